# Optimizing an MI355X kernel written in HIP

```python
import math
import jax, jax.numpy as jnp
from jax import lax
import numpy as np

D_MODEL = 1024
BATCH = 8
SEQ = 4096
DEPTH = 2

MIX_WIDTH = D_MODEL
SGU_WIDTH = MIX_WIDTH // 2
SGU_HEADS = 4
SGU_HEAD_DIM = SGU_WIDTH // SGU_HEADS
CHUNK = 128
ATT_WIDTH = MIX_WIDTH - SGU_WIDTH
ATT_HEADS = 8
ATT_HEAD_DIM = ATT_WIDTH // ATT_HEADS
DILATED_PATTERNS = ((128, 1), (512, 4), (2048, 16))
ATT_BLOCK = 128
ROPE_THETA = 10000.0
D_FF = 2816
IN_WIDTH = 2 * SGU_WIDTH + 3 * ATT_WIDTH
N_ADA = 9
EPS = 1e-6

kernel_name = "hybrid_sgu_dilated_macaron_adaln"


def rmsnorm(x, g):
    xf = x.astype(jnp.float32)
    y = xf * lax.rsqrt(jnp.mean(xf * xf, axis=-1, keepdims=True) + EPS)
    return (y * g.astype(jnp.float32)).astype(x.dtype)


def modulate(h, shift, scale):
    return h * (1.0 + scale[:, None, :]) + shift[:, None, :]


def swiglu(y, w_gate, w_up, w_down):
    return (jax.nn.silu(y @ w_gate) * (y @ w_up)) @ w_down


def rope_tables(S, dh, dtype):
    inv = ROPE_THETA ** (-jnp.arange(0, dh, 2, dtype=jnp.float32) / dh)
    ang = jnp.arange(S, dtype=jnp.float32)[:, None] * inv[None, :]
    ang = jnp.concatenate([ang, ang], axis=-1)
    return jnp.cos(ang)[:, None, :].astype(dtype), jnp.sin(ang)[:, None, :].astype(dtype)


def apply_rope(t, cos, sin):
    half = t.shape[-1] // 2
    rot = jnp.concatenate([-t[..., half:], t[..., :half]], axis=-1)
    return t * cos + rot * sin


def spatial_gating(u, v, ln_g, ln_b, w_s, b_s):
    B, S, H, dh = u.shape
    u = jax.nn.gelu(u)
    v = jax.nn.gelu(v)
    vf = v.astype(jnp.float32)
    mu = jnp.mean(vf, axis=-1, keepdims=True)
    var = jnp.mean(jnp.square(vf - mu), axis=-1, keepdims=True)
    vn = ((vf - mu) * lax.rsqrt(var + EPS)).astype(v.dtype) * ln_g + ln_b
    vc = vn.reshape(B, S // CHUNK, CHUNK, H, dh)
    causal = jnp.tril(jnp.ones((CHUNK, CHUNK), dtype=bool))
    ws = jnp.where(causal[None], w_s, jnp.zeros_like(w_s))
    z = jnp.einsum('hij,bnjhc->bnihc', ws, vc) + b_s.T[None, None, :, :, None]
    return u * z.reshape(B, S, H, dh)


def dilated_branch(q, k, v, window, dil):
    B, S, H, dh = q.shape
    n_back = window // dil
    span = dil * ATT_BLOCK
    S_pad = -(-S // span) * span
    L = S_pad // dil
    nb = L // ATT_BLOCK

    def to_blocks(t):
        t = jnp.pad(t, ((0, 0), (0, S_pad - S), (0, 0), (0, 0)))
        t = t.reshape(B, L, dil, H, dh).transpose(0, 2, 3, 1, 4)
        return t.reshape(B, dil, H, nb, ATT_BLOCK, dh)

    def with_prev(t):
        prev = jnp.concatenate([jnp.zeros_like(t[:, :, :, :1]), t[:, :, :, :-1]], axis=3)
        return jnp.concatenate([prev, t], axis=4)

    qb = to_blocks(q)
    kk = with_prev(to_blocks(k))
    vv = with_prev(to_blocks(v))
    s = jnp.einsum('brhnqd,brhnkd->brhnqk', qb, kk,
                   preferred_element_type=jnp.float32) * (1.0 / math.sqrt(dh))
    qi = jnp.arange(ATT_BLOCK)[:, None]
    ki = jnp.arange(2 * ATT_BLOCK)[None, :]
    diff = qi + ATT_BLOCK - ki
    band = (diff >= 0) & (diff <= n_back)
    valid = (jnp.arange(nb)[:, None, None] > 0) | (ki[None] >= ATT_BLOCK)
    mask = band[None] & valid
    s = jnp.where(mask, s, -jnp.inf)
    m = jnp.max(s, axis=-1, keepdims=True)
    p = jnp.exp(s - m)
    den = jnp.sum(p, axis=-1, keepdims=True)
    o = jnp.einsum('brhnqk,brhnkd->brhnqd', p, vv.astype(jnp.float32)) / den
    lse = (m + jnp.log(den))[..., 0]
    o = o.reshape(B, dil, H, L, dh).transpose(0, 3, 1, 2, 4).reshape(B, S_pad, H, dh)[:, :S]
    lse = lse.reshape(B, dil, H, L).transpose(0, 3, 1, 2).reshape(B, S_pad, H)[:, :S]
    return o, lse


def dilated_mixture(q, k, v):
    outs, lses = [], []
    for window, dil in DILATED_PATTERNS:
        o, lse = dilated_branch(q, k, v, window, dil)
        outs.append(o)
        lses.append(lse)
    w = jax.nn.softmax(jnp.stack(lses, axis=0), axis=0)
    o = jnp.sum(w[..., None] * jnp.stack(outs, axis=0), axis=0)
    return o.astype(q.dtype)


def setup_inputs(seed: int = 0) -> dict:
    key = jax.random.key(seed)
    ks = jax.random.split(key, 20)
    f32 = jnp.float32
    nrm = lambda k, shape, scale: jax.random.normal(k, shape, f32) * scale
    return {
        "x": nrm(ks[0], (BATCH, SEQ, D_MODEL), 1.0),
        "c": nrm(ks[1], (BATCH, D_MODEL), 1.0),
        "ada_w": nrm(ks[2], (DEPTH, D_MODEL, N_ADA * D_MODEL), D_MODEL ** -0.5),
        "ada_b": nrm(ks[3], (DEPTH, N_ADA * D_MODEL), 0.02),
        "norm_g": 1.0 + nrm(ks[4], (DEPTH, 3, D_MODEL), 0.02),
        "ffn1_wg": nrm(ks[5], (DEPTH, D_MODEL, D_FF), D_MODEL ** -0.5),
        "ffn1_wu": nrm(ks[6], (DEPTH, D_MODEL, D_FF), D_MODEL ** -0.5),
        "ffn1_wd": nrm(ks[7], (DEPTH, D_FF, D_MODEL), D_FF ** -0.5),
        "ffn2_wg": nrm(ks[8], (DEPTH, D_MODEL, D_FF), D_MODEL ** -0.5),
        "ffn2_wu": nrm(ks[9], (DEPTH, D_MODEL, D_FF), D_MODEL ** -0.5),
        "ffn2_wd": nrm(ks[10], (DEPTH, D_FF, D_MODEL), D_FF ** -0.5),
        "w_in": nrm(ks[11], (DEPTH, D_MODEL, IN_WIDTH), D_MODEL ** -0.5),
        "sgu_ln_g": 1.0 + nrm(ks[12], (DEPTH, SGU_HEADS, SGU_HEAD_DIM), 0.02),
        "sgu_ln_b": nrm(ks[13], (DEPTH, SGU_HEADS, SGU_HEAD_DIM), 0.02),
        "sgu_w": nrm(ks[14], (DEPTH, SGU_HEADS, CHUNK, CHUNK), CHUNK ** -0.5),
        "sgu_b": 1.0 + nrm(ks[15], (DEPTH, SGU_HEADS, CHUNK), 0.02),
        "w_out": nrm(ks[16], (DEPTH, MIX_WIDTH, D_MODEL), MIX_WIDTH ** -0.5),
        "final_g": 1.0 + nrm(ks[17], (D_MODEL,), 0.02),
    }


def reference(x, c, ada_w, ada_b, norm_g, ffn1_wg, ffn1_wu, ffn1_wd, ffn2_wg, ffn2_wu, ffn2_wd,
              w_in, sgu_ln_g, sgu_ln_b, sgu_w, sgu_b, w_out, final_g):
    B, S, D = x.shape
    cos, sin = rope_tables(S, ATT_HEAD_DIM, x.dtype)
    c_act = jax.nn.silu(c)
    h = x
    for l in range(DEPTH):
        mod = c_act @ ada_w[l] + ada_b[l]
        sh1, sc1, g1, sh2, sc2, g2, sh3, sc3, g3 = jnp.split(mod, N_ADA, axis=-1)

        y = modulate(rmsnorm(h, norm_g[l, 0]), sh1, sc1)
        h = h + 0.5 * g1[:, None, :] * swiglu(y, ffn1_wg[l], ffn1_wu[l], ffn1_wd[l])

        y = modulate(rmsnorm(h, norm_g[l, 1]), sh2, sc2)
        proj = y @ w_in[l]
        u_a, v_a, q_b, k_b, v_b = jnp.split(
            proj, [SGU_WIDTH, 2 * SGU_WIDTH, 2 * SGU_WIDTH + ATT_WIDTH, 2 * SGU_WIDTH + 2 * ATT_WIDTH], axis=-1)
        u_a = u_a.reshape(B, S, SGU_HEADS, SGU_HEAD_DIM)
        v_a = v_a.reshape(B, S, SGU_HEADS, SGU_HEAD_DIM)
        out_a = spatial_gating(u_a, v_a, sgu_ln_g[l], sgu_ln_b[l], sgu_w[l], sgu_b[l])
        q_b = apply_rope(q_b.reshape(B, S, ATT_HEADS, ATT_HEAD_DIM), cos, sin)
        k_b = apply_rope(k_b.reshape(B, S, ATT_HEADS, ATT_HEAD_DIM), cos, sin)
        v_b = v_b.reshape(B, S, ATT_HEADS, ATT_HEAD_DIM)
        out_b = dilated_mixture(q_b, k_b, v_b)
        mixed = jnp.concatenate([out_a.reshape(B, S, SGU_WIDTH), out_b.reshape(B, S, ATT_WIDTH)], axis=-1)
        h = h + g2[:, None, :] * (mixed @ w_out[l])

        y = modulate(rmsnorm(h, norm_g[l, 2]), sh3, sc3)
        h = h + 0.5 * g3[:, None, :] * swiglu(y, ffn2_wg[l], ffn2_wu[l], ffn2_wd[l])
    return rmsnorm(h, final_g)
```

```cpp
#include <hip/hip_runtime.h>
#include <hip/hip_cooperative_groups.h>
#include <cstdio>
namespace cg = cooperative_groups;

#define LAS __attribute__((address_space(3)))
#define DI __device__ __forceinline__
typedef unsigned short bf16_t;
typedef short bf16x8 __attribute__((ext_vector_type(8)));
typedef short s16x4 __attribute__((ext_vector_type(4)));
typedef float f32x4 __attribute__((ext_vector_type(4)));
typedef float f32x2 __attribute__((ext_vector_type(2)));
typedef float f32x16 __attribute__((ext_vector_type(16)));
typedef unsigned u32x4 __attribute__((ext_vector_type(4)));
typedef unsigned u32x2 __attribute__((ext_vector_type(2)));

constexpr int DM = 1024, NB = 8, SEQ = 4096, MTOK = NB * SEQ, FF = 2816, INW = 2560, NADA = 9;
constexpr int NTHR = 512;
constexpr float EPS = 1e-6f;

constexpr size_t SZ_UP = (size_t)2 * FF * DM * 2;
constexpr size_t SZ_DN = (size_t)DM * FF * 2;
constexpr size_t SZ_IN = (size_t)INW * DM * 2;
constexpr size_t SZ_OUT = (size_t)DM * DM * 2;
constexpr size_t WS_UP = 0;
constexpr size_t WS_DN = WS_UP + 4 * SZ_UP;
constexpr size_t WS_IN = WS_DN + 4 * SZ_DN;
constexpr size_t WS_OUT = WS_IN + 2 * SZ_IN;
constexpr size_t WS_SGUW = WS_OUT + 2 * SZ_OUT;
constexpr size_t WS_MOD = WS_SGUW + (size_t)2 * 4 * 128 * 128 * 2;
constexpr size_t WS_ROPE = WS_MOD + (size_t)2 * 8 * 9216 * 4;
constexpr size_t WS_Y = WS_ROPE + (size_t)4096 * 32 * 8;
constexpr size_t WS_PG = WS_Y + (size_t)MTOK * DM * 2;
constexpr size_t WS_END = WS_PG + (size_t)MTOK * FF * 2;

struct Params {
    const float *x, *c, *ada_w, *ada_b, *norm_g, *f1g, *f1u, *f1d, *f2g, *f2u, *f2d, *w_in, *sgu_ln_g, *sgu_ln_b, *sgu_w, *sgu_b, *w_out, *final_g;
    float* out; unsigned char* ws;
};

DI int launder_v(int x) { asm volatile("" : "+v"(x)); return x; }
template <class T> DI T* launder_p(T* q) { asm volatile("" : "+s"(q)); return q; }
DI float bf2f(unsigned short v) { return __uint_as_float((unsigned)v << 16); }
DI unsigned short f2bf(float f) { unsigned u = __float_as_uint(f); u += 0x7fffu + ((u >> 16) & 1u); return (unsigned short)(u >> 16); }
DI unsigned cvt_pk_bf16(float lo, float hi) { unsigned r; asm("v_cvt_pk_bf16_f32 %0, %1, %2" : "=v"(r) : "v"(lo), "v"(hi)); return r; }
DI float fast_exp2(float x) { return __builtin_amdgcn_exp2f(x); }
DI float fast_rcp(float x) { return __builtin_amdgcn_rcpf(x); }
DI float silu_f(float x) { return x * fast_rcp(1.0f + fast_exp2(-1.4426950409f * x)); }
DI float gelu_tanh_f(float x) { const float t = 0.7978845608f * (x + 0.044715f * x * x * x); return x * fast_rcp(1.0f + fast_exp2(-2.8853900818f * t)); }

namespace pg8 {
constexpr int BM = 256, BK = 64, HALF = 128, HTB = HALF * BK * 2, STAGE_BYTES = 8 * HTB, NXCD = 8, WGM = 8;
DI int lds_byte(int r, int c) { const int st = (r >> 4) * 2 + (c >> 5), rr = r & 15, cc = c & 31, ob = rr * 64 + cc * 2; return st * 1024 + (ob ^ (((ob >> 9) & 1) << 5)); }
DI void stage_rc(int b, int& R, int& C) { const int st = b / 1024, sb = b % 1024, swz = sb ^ (((sb >> 9) & 1) << 5); R = (st >> 1) * 16 + swz / 64; C = (st & 1) * 32 + (swz % 64) / 2; }
DI int perm32(int rho) { const int n = rho >> 4, i = rho & 15; return 8 * (i >> 2) + 4 * n + (i & 3); }
struct Unit { int pm, pn; };
struct Gemm { const bf16_t* A; const bf16_t* Bt; int M, N, K; };
struct StaticOrder {
    int nM, nN, nwg, G, c;
    DI void init(int M, int N, int G_, int c_) { nM = M / BM; nN = N / BM; nwg = nM * nN; G = G_; c = c_; }
    DI bool next(int i, Unit& u) const {
        const long L = (long)i * G + c; if (L >= nwg) return false;
        int wgid = (int)L; { const int q = nwg / NXCD, r = nwg % NXCD, xcd = wgid % NXCD, off = wgid / NXCD; wgid = (xcd < r ? xcd * (q + 1) : r * (q + 1) + (xcd - r) * q) + off; }
        const int nig = WGM * nN, gid = wgid / nig, fm = gid * WGM, gsz = (nM - fm) < WGM ? (nM - fm) : WGM;
        u.pm = fm + ((wgid % nig) % gsz); u.pn = (wgid % nig) / gsz; return true;
    }
};

template <class Epi>
DI void gemm_phase(LAS unsigned char* lds, const Gemm g, const StaticOrder& S, const Epi& E) {
    const int tid = launder_v(threadIdx.x), wid = __builtin_amdgcn_readfirstlane(tid >> 6), lane = tid & 63, wr = wid >> 2, wc = wid & 3, fr = lane & 15, fq = lane >> 4;
    const int K = g.K, nt = K / BK;
    unsigned voffA[2], voffB[2];
#pragma unroll
    for (int i = 0; i < 2; ++i) { int R, C; stage_rc(tid * 16 + i * 8192, R, C); const int Rb = Epi::PERM ? ((R & ~31) + perm32(R & 31)) : R;
        voffA[i] = (unsigned)(R * K + C) * 2u; voffB[i] = (unsigned)(Rb * K + C) * 2u; }
    const size_t kstep = (size_t)(BK * 2);
    const size_t hstep = (size_t)HALF * K * 2;
    const size_t tstep = 2 * hstep;
    const unsigned ldsw = (unsigned)wid * 1024u;
    const int aoff = lds_byte(wr * 64 + fr, fq * 8), boff = lds_byte(wc * 32 + fr, fq * 8);
#define PG8_SA(b, h) (((b) * 2 + (h)) * HTB)
#define PG8_SB(b, h) ((4 + (b) * 2 + (h)) * HTB)
#define PG8_STAGE(bufoff, gbase, voff) do { _Pragma("unroll") for (int _i = 0; _i < 2; ++_i) \
        __builtin_amdgcn_global_load_lds((const unsigned*)((const char*)(gbase) + (voff)[_i]), (LAS unsigned*)(lds + (bufoff) + ldsw + _i * 8192), 16, 0, 0); } while (0)
#define PG8_LDA(dst, b, h) do { _Pragma("unroll") for (int m = 0; m < 4; ++m) _Pragma("unroll") for (int k = 0; k < 2; ++k) dst[m][k] = *(const LAS bf16x8*)(lds + PG8_SA(b, h) + aoff + m * 2048 + k * 1024); } while (0)
#define PG8_LDB(dst, b, h) do { _Pragma("unroll") for (int n = 0; n < 2; ++n) _Pragma("unroll") for (int k = 0; k < 2; ++k) dst[n][k] = *(const LAS bf16x8*)(lds + PG8_SB(b, h) + boff + n * 2048 + k * 1024); } while (0)
#define PG8_MMA(ai, bj, At, Bt) do { __builtin_amdgcn_s_setprio(1); _Pragma("unroll") for (int m = 0; m < 4; ++m) _Pragma("unroll") for (int n = 0; n < 2; ++n) _Pragma("unroll") for (int k = 0; k < 2; ++k) \
        acc[ai][bj][m][n] = __builtin_amdgcn_mfma_f32_16x16x32_bf16(Bt[n][k], At[m][k], acc[ai][bj][m][n], 0, 0, 0); __builtin_amdgcn_s_setprio(0); } while (0)
#define PG8_WAIT_V(n) asm volatile("s_waitcnt vmcnt(" #n ")" ::: "memory")
#define PG8_WAIT_L(n) asm volatile("s_waitcnt lgkmcnt(" #n ")" ::: "memory")
#define PG8_BAR __builtin_amdgcn_s_barrier()
#define PG8_SCHED __builtin_amdgcn_sched_barrier(0)
    Unit cur, nxt; int ui = 0;
    if (!S.next(0, cur)) return;
    f32x4 acc[2][2][4][2];
#pragma unroll
    for (int a = 0; a < 2; ++a)
#pragma unroll
        for (int b = 0; b < 2; ++b)
#pragma unroll
            for (int m = 0; m < 4; ++m)
#pragma unroll
                for (int n = 0; n < 2; ++n) acc[a][b][m][n] = (f32x4){0.f, 0.f, 0.f, 0.f};
    bf16x8 At[4][2], B0[2][2], B1[2][2];
    const char* cA = (const char*)g.A + (size_t)cur.pm * tstep; const char* cB = (const char*)g.Bt + (size_t)cur.pn * tstep;
    PG8_STAGE(PG8_SB(0, 0), cB, voffB); PG8_STAGE(PG8_SA(0, 0), cA, voffA); PG8_STAGE(PG8_SB(0, 1), cB + hstep, voffB); PG8_STAGE(PG8_SA(0, 1), cA + hstep, voffA);
    if (wr == 1) PG8_BAR;
    PG8_WAIT_V(4); PG8_BAR;
    PG8_STAGE(PG8_SB(1, 0), cB + kstep, voffB); PG8_STAGE(PG8_SA(1, 0), cA + kstep, voffA); PG8_STAGE(PG8_SB(1, 1), cB + hstep + kstep, voffB);
    PG8_WAIT_V(6); PG8_BAR;
    for (;;) {
        const bool has_next = S.next(ui + 1, nxt);
        const char* nA = has_next ? (const char*)g.A + (size_t)nxt.pm * tstep : cA; const char* nB = has_next ? (const char*)g.Bt + (size_t)nxt.pn * tstep : cB;
        for (int t = 0; t < nt; t += 2) {
            const bool last = (t == nt - 2);
            const char* a1 = cA + (size_t)(t + 1) * kstep;
            const char* a2 = last ? nA : cA + (size_t)(t + 2) * kstep; const char* b2 = last ? nB : cB + (size_t)(t + 2) * kstep;
            const char* a3 = a2 + kstep; const char* b3 = b2 + kstep;
            PG8_LDB(B0, 0, 0); PG8_SCHED; PG8_LDA(At, 0, 0); PG8_STAGE(PG8_SA(1, 1), a1 + hstep, voffA);
            PG8_WAIT_L(8); PG8_BAR; PG8_WAIT_L(0); PG8_MMA(0, 0, At, B0); PG8_BAR; PG8_SCHED;
            PG8_LDB(B1, 0, 1); PG8_STAGE(PG8_SB(0, 0), b2, voffB);
            PG8_BAR; PG8_WAIT_L(0); PG8_MMA(0, 1, At, B1); PG8_BAR;
            PG8_LDA(At, 0, 1); PG8_STAGE(PG8_SA(0, 0), a2, voffA);
            PG8_BAR; PG8_WAIT_L(0); PG8_MMA(1, 0, At, B0); PG8_BAR; PG8_SCHED;
            PG8_STAGE(PG8_SB(0, 1), b2 + hstep, voffB);
            PG8_WAIT_V(6); PG8_BAR; PG8_MMA(1, 1, At, B1); PG8_BAR;
            PG8_LDB(B0, 1, 0); PG8_SCHED; PG8_LDA(At, 1, 0); PG8_STAGE(PG8_SA(0, 1), a2 + hstep, voffA);
            PG8_WAIT_L(8); PG8_BAR; PG8_WAIT_L(0); PG8_MMA(0, 0, At, B0); PG8_BAR; PG8_SCHED;
            PG8_LDB(B1, 1, 1); PG8_STAGE(PG8_SB(1, 0), b3, voffB);
            PG8_BAR; PG8_WAIT_L(0); PG8_MMA(0, 1, At, B1); PG8_BAR;
            PG8_LDA(At, 1, 1); PG8_STAGE(PG8_SA(1, 0), a3, voffA);
            PG8_BAR; PG8_WAIT_L(0); PG8_MMA(1, 0, At, B0); PG8_BAR; PG8_SCHED;
            PG8_STAGE(PG8_SB(1, 1), b3 + hstep, voffB);
            PG8_WAIT_V(6); PG8_BAR; PG8_MMA(1, 1, At, B1); PG8_BAR;
        }
        E(acc, cur, wr, wc, fr, fq);
        if (!has_next) break;
#pragma unroll
        for (int a = 0; a < 2; ++a)
#pragma unroll
            for (int b = 0; b < 2; ++b)
#pragma unroll
                for (int m = 0; m < 4; ++m)
#pragma unroll
                    for (int n = 0; n < 2; ++n) acc[a][b][m][n] = (f32x4){0.f, 0.f, 0.f, 0.f};
        cur = nxt; cA = nA; cB = nB; ++ui;
    }
    PG8_WAIT_V(0);
    if (wr == 0) PG8_BAR;
    PG8_BAR;
#undef PG8_SA
#undef PG8_SB
#undef PG8_STAGE
#undef PG8_LDA
#undef PG8_LDB
#undef PG8_MMA
#undef PG8_WAIT_V
#undef PG8_WAIT_L
#undef PG8_BAR
#undef PG8_SCHED
}
}

struct EpiSwiglu {
    static constexpr bool PERM = true;
    bf16_t* G;
    DI void operator()(const f32x4 (&acc)[2][2][4][2], const pg8::Unit& u, int wr, int wc, int fr, int fq) const {
        const int row0 = u.pm * 256 + wr * 64 + fr, col0 = u.pn * 128 + wc * 32 + 8 * fq;
#pragma unroll
        for (int ai = 0; ai < 2; ++ai)
#pragma unroll
            for (int m = 0; m < 4; ++m) {
                bf16_t* rowp = G + (size_t)(row0 + ai * 128 + m * 16) * FF + col0;
                const f32x4 g0 = acc[ai][0][m][0], g1 = acc[ai][0][m][1], u0 = acc[ai][1][m][0], u1 = acc[ai][1][m][1];
                u32x4 w;
                w.x = cvt_pk_bf16(silu_f(g0[0]) * u0[0], silu_f(g0[1]) * u0[1]); w.y = cvt_pk_bf16(silu_f(g0[2]) * u0[2], silu_f(g0[3]) * u0[3]);
                w.z = cvt_pk_bf16(silu_f(g1[0]) * u1[0], silu_f(g1[1]) * u1[1]); w.w = cvt_pk_bf16(silu_f(g1[2]) * u1[2], silu_f(g1[3]) * u1[3]);
                *(u32x4*)rowp = w;
            }
    }
};
struct EpiResid {
    static constexpr bool PERM = false;
    const float* hin; float* hout; const float* gate; float gscale;
    DI void operator()(const f32x4 (&acc)[2][2][4][2], const pg8::Unit& u, int wr, int wc, int fr, int fq) const {
        const int row0 = u.pm * 256 + wr * 64 + fr, col0 = u.pn * 256 + wc * 32 + 4 * fq, b = (u.pm * 256) / SEQ;
        f32x4 gv[2][2];
#pragma unroll
        for (int bj = 0; bj < 2; ++bj)
#pragma unroll
            for (int n = 0; n < 2; ++n) gv[bj][n] = *(const f32x4*)(gate + (size_t)b * (NADA * DM) + col0 + bj * 128 + n * 16) * gscale;
#pragma unroll
        for (int ai = 0; ai < 2; ++ai)
#pragma unroll
            for (int m = 0; m < 4; ++m) {
                const size_t off = (size_t)(row0 + ai * 128 + m * 16) * DM + col0;
#pragma unroll
                for (int bj = 0; bj < 2; ++bj)
#pragma unroll
                    for (int n = 0; n < 2; ++n) {
                        const f32x4 hv = *(const f32x4*)(hin + off + bj * 128 + n * 16);
                        *(f32x4*)(hout + off + bj * 128 + n * 16) = hv + gv[bj][n] * acc[ai][bj][m][n];
                    }
            }
    }
};
struct EpiIn {
    static constexpr bool PERM = true;
    bf16_t* P; const float* rope;
    DI void operator()(const f32x4 (&acc)[2][2][4][2], const pg8::Unit& u, int wr, int wc, int fr, int fq) const {
        const int row0 = u.pm * 256 + wr * 64 + fr, col0 = u.pn * 256 + wc * 32 + 8 * fq, kind = u.pn >> 1;
        const int i0 = 16 * (wc & 1) + 4 * fq;
        const float qs = (kind == 2) ? 0.125f * 1.4426950409f : 1.0f;
#pragma unroll
        for (int ai = 0; ai < 2; ++ai)
#pragma unroll
            for (int m = 0; m < 4; ++m) {
                const int row = row0 + ai * 128 + m * 16, pos = row & (SEQ - 1);
                bf16_t* rowp = P + (size_t)row * INW + col0;
                f32x4 cs0 = {1.f, 0.f, 1.f, 0.f}, cs1 = {1.f, 0.f, 1.f, 0.f};
                if (kind == 2 || kind == 3) { const f32x4* rp = (const f32x4*)(rope + ((size_t)pos * 32 + i0) * 2); cs0 = rp[0]; cs1 = rp[1]; }
#pragma unroll
                for (int bj = 0; bj < 2; ++bj) {
                    f32x4 v0 = acc[ai][bj][m][0], v1 = acc[ai][bj][m][1];
                    if (kind <= 1) {
#pragma unroll
                        for (int j = 0; j < 4; ++j) { v0[j] = gelu_tanh_f(v0[j]); v1[j] = gelu_tanh_f(v1[j]); }
                    } else if (kind <= 3) {
                        const float c[4] = {cs0[0], cs0[2], cs1[0], cs1[2]}, s[4] = {cs0[1], cs0[3], cs1[1], cs1[3]};
#pragma unroll
                        for (int j = 0; j < 4; ++j) { const float x1 = v0[j], x2 = v1[j]; v0[j] = (x1 * c[j] - x2 * s[j]) * qs; v1[j] = (x2 * c[j] + x1 * s[j]) * qs; }
                    }
                    u32x4 w; w.x = cvt_pk_bf16(v0[0], v0[1]); w.y = cvt_pk_bf16(v0[2], v0[3]); w.z = cvt_pk_bf16(v1[0], v1[1]); w.w = cvt_pk_bf16(v1[2], v1[3]);
                    *(u32x4*)(rowp + bj * 128) = w;
                }
            }
    }
};

DI void tr_tile(const float* src, int ld_src, int srccol0, int k0, bf16_t* dst, int ld_dst, int n0, bool rperm, LAS float* tile, int tid) {
#pragma unroll
    for (int i = 0; i < 2; ++i) {
        const int idx = tid + i * NTHR, row = idx >> 4, c4 = idx & 15;
        const f32x4 v = *(const f32x4*)(src + (size_t)(k0 + row) * ld_src + srccol0 + c4 * 4);
        LAS float* t = tile + row * 65 + c4 * 4; t[0] = v[0]; t[1] = v[1]; t[2] = v[2]; t[3] = v[3];
    }
    __syncthreads();
    const int p = tid >> 3, kc = (tid & 7) * 8;
    const int pp = rperm ? (4 * (p >> 3) + (p & 3) + 32 * ((p >> 2) & 1)) : p;
    float v[8];
#pragma unroll
    for (int j = 0; j < 8; ++j) v[j] = tile[(kc + j) * 65 + pp];
    u32x4 w; w.x = cvt_pk_bf16(v[0], v[1]); w.y = cvt_pk_bf16(v[2], v[3]); w.z = cvt_pk_bf16(v[4], v[5]); w.w = cvt_pk_bf16(v[6], v[7]);
    *(u32x4*)(dst + (size_t)(n0 + p) * ld_dst + k0 + kc) = w;
    __syncthreads();
}

constexpr int IT_MOD = 288;
constexpr int IT_ROPE = 256, IT_SGUW = 256;
constexpr int T_UP = 88 * 16, T_DN = 16 * 44, T_IN = 40 * 16, T_OUT = 16 * 16;
constexpr int IT_UP0 = IT_MOD + IT_ROPE + IT_SGUW, IT_DN0 = IT_UP0 + 4 * T_UP, IT_IN0 = IT_DN0 + 4 * T_DN, IT_OUT0 = IT_IN0 + 2 * T_IN, IT_END = IT_OUT0 + 2 * T_OUT;

DI void prelude_phase(const Params& p, LAS unsigned char* lds, int tid) {
    unsigned char* ws = p.ws;
    for (int it = blockIdx.x; it < IT_END; it += gridDim.x) {
        if (it < IT_MOD) {
            const int l = it / 144, cb = it % 144;
            LAS float* s = (LAS float*)lds; LAS float* red = (LAS float*)(lds + 32768);
            for (int i = tid; i < NB * DM; i += NTHR) s[i] = silu_f(p.c[i]);
            __syncthreads();
            const int cp = tid & 31, kg = tid >> 5;
            float a[8][2];
#pragma unroll
            for (int b = 0; b < 8; ++b) { a[b][0] = 0.f; a[b][1] = 0.f; }
            const float* w = p.ada_w + (size_t)l * DM * (NADA * DM) + (size_t)(kg * 64) * (NADA * DM) + cb * 64 + cp * 2;
#pragma unroll 4
            for (int k = 0; k < 64; ++k) {
                const f32x2 wv = *(const f32x2*)(w + (size_t)k * (NADA * DM));
#pragma unroll
                for (int b = 0; b < 8; ++b) { const float sv = s[b * DM + kg * 64 + k]; a[b][0] += sv * wv.x; a[b][1] += sv * wv.y; }
            }
#pragma unroll
            for (int b = 0; b < 8; ++b) { red[(kg * 8 + b) * 64 + cp * 2] = a[b][0]; red[(kg * 8 + b) * 64 + cp * 2 + 1] = a[b][1]; }
            __syncthreads();
            { const int b = tid >> 6, col = tid & 63; float sum = 0.f;
#pragma unroll
              for (int g = 0; g < 16; ++g) sum += red[(g * 8 + b) * 64 + col];
              const int n = cb * 64 + col;
              ((float*)(ws + WS_MOD))[((size_t)l * 8 + b) * (NADA * DM) + n] = sum + p.ada_b[(size_t)l * (NADA * DM) + n]; }
            __syncthreads();
        } else if (it < IT_MOD + IT_ROPE) {
            const int idx = (it - IT_MOD) * NTHR + tid, pos = idx >> 5, i = idx & 31;
            const float inv = exp2f(-(float)i * (13.287712379549449f / 32.0f));
            const float ang = (float)pos * inv;
            const double rev = (double)ang * 0.15915494309189535;
            const float fr = (float)(rev - floor(rev));
            f32x2 cs; cs.x = __builtin_amdgcn_cosf(fr); cs.y = __builtin_amdgcn_sinf(fr);
            ((f32x2*)(ws + WS_ROPE))[idx] = cs;
        } else if (it < IT_UP0) {
            const int idx = (it - IT_MOD - IT_ROPE) * NTHR + tid, j = idx & 127, i = (idx >> 7) & 127;
            ((bf16_t*)(ws + WS_SGUW))[idx] = (j <= i) ? f2bf(p.sgu_w[idx]) : (bf16_t)0;
        } else if (it < IT_DN0) {
            const int r = it - IT_UP0, lf = r / T_UP, t = r % T_UP, nb = t >> 4, kb = t & 15, l = lf >> 1, f = lf & 1;
            const int n0 = nb * 64, tl = n0 >> 8, half = (n0 >> 7) & 1, j0 = n0 & 127;
            const float* src = (f ? (half ? p.f2u : p.f2g) : (half ? p.f1u : p.f1g)) + (size_t)l * DM * FF;
            tr_tile(src, FF, tl * 128 + j0, kb * 64, (bf16_t*)(ws + WS_UP + (size_t)lf * SZ_UP), DM, n0, false, (LAS float*)lds, tid);
        } else if (it < IT_IN0) {
            const int r = it - IT_DN0, lf = r / T_DN, t = r % T_DN, nb = t / 44, kb = t % 44, l = lf >> 1, f = lf & 1;
            const float* src = (f ? p.f2d : p.f1d) + (size_t)l * FF * DM;
            tr_tile(src, DM, nb * 64, kb * 64, (bf16_t*)(ws + WS_DN + (size_t)lf * SZ_DN), FF, nb * 64, false, (LAS float*)lds, tid);
        } else if (it < IT_OUT0) {
            const int r = it - IT_IN0, l = r / T_IN, t = r % T_IN, nb = t >> 4, kb = t & 15, n0 = nb * 64;
            tr_tile(p.w_in + (size_t)l * DM * INW, INW, n0, kb * 64, (bf16_t*)(ws + WS_IN + (size_t)l * SZ_IN), DM, n0, (n0 >= 1024 && n0 < 2048), (LAS float*)lds, tid);
        } else {
            const int r = it - IT_OUT0, l = r / T_OUT, t = r % T_OUT, nb = t >> 4, kb = t & 15;
            tr_tile(p.w_out + (size_t)l * DM * DM, DM, nb * 64, kb * 64, (bf16_t*)(ws + WS_OUT + (size_t)l * SZ_OUT), DM, nb * 64, false, (LAS float*)lds, tid);
        }
    }
}

DI float wave_sum(float v) {
#pragma unroll
    for (int o = 32; o >= 1; o >>= 1) v += __shfl_xor(v, o);
    return v;
}
DI void norm_phase(const float* h, const float* g, const float* sh, const float* sc, bf16_t* y, int tid) {
    tid = launder_v(tid);
    const int wave = tid >> 6, lane = tid & 63;
    for (int row = blockIdx.x * 8 + wave; row < MTOK; row += gridDim.x * 8) {
        const int b = row / SEQ;
        const float* hp = h + (size_t)row * DM;
        f32x4 v[4]; float ss = 0.f;
#pragma unroll
        for (int i = 0; i < 4; ++i) { v[i] = *(const f32x4*)(hp + i * 256 + lane * 4); ss += v[i][0] * v[i][0] + v[i][1] * v[i][1] + v[i][2] * v[i][2] + v[i][3] * v[i][3]; }
        ss = wave_sum(ss);
        const float rstd = rsqrtf(ss * (1.0f / DM) + EPS);
#pragma unroll
        for (int i = 0; i < 4; ++i) {
            const int col = i * 256 + lane * 4;
            const f32x4 gv = *(const f32x4*)(g + col), sv = *(const f32x4*)(sc + (size_t)b * (NADA * DM) + col), hv = *(const f32x4*)(sh + (size_t)b * (NADA * DM) + col);
            float o[4];
#pragma unroll
            for (int j = 0; j < 4; ++j) o[j] = v[i][j] * rstd * gv[j] * (1.0f + sv[j]) + hv[j];
            u32x2 w; w.x = cvt_pk_bf16(o[0], o[1]); w.y = cvt_pk_bf16(o[2], o[3]);
            *(u32x2*)(y + (size_t)row * DM + col) = w;
        }
    }
}
DI void final_norm_phase(float* h, const float* g, int tid) {
    const int wave = tid >> 6, lane = tid & 63;
    for (int row = blockIdx.x * 8 + wave; row < MTOK; row += gridDim.x * 8) {
        float* hp = h + (size_t)row * DM;
        f32x4 v[4]; float ss = 0.f;
#pragma unroll
        for (int i = 0; i < 4; ++i) { v[i] = *(const f32x4*)(hp + i * 256 + lane * 4); ss += v[i][0] * v[i][0] + v[i][1] * v[i][1] + v[i][2] * v[i][2] + v[i][3] * v[i][3]; }
        ss = wave_sum(ss);
        const float rstd = rsqrtf(ss * (1.0f / DM) + EPS);
#pragma unroll
        for (int i = 0; i < 4; ++i) { const int col = i * 256 + lane * 4; const f32x4 gv = *(const f32x4*)(g + col); *(f32x4*)(hp + col) = v[i] * rstd * gv; }
    }
}

#define MFMA32(a, b, c) __builtin_amdgcn_mfma_f32_32x32x16_bf16((a), (b), (c), 0, 0, 0)
DI bf16x8 pack8(const f32x16& x, int s) {
    u32x4 p; p.x = cvt_pk_bf16(x[8 * s], x[8 * s + 1]); p.y = cvt_pk_bf16(x[8 * s + 2], x[8 * s + 3]); p.z = cvt_pk_bf16(x[8 * s + 4], x[8 * s + 5]); p.w = cvt_pk_bf16(x[8 * s + 6], x[8 * s + 7]);
    return __builtin_bit_cast(bf16x8, p);
}

DI void sgu_item(const Params& p, int l, int item, LAS unsigned char* lds, int tid) {
    tid = launder_v(tid); unsigned char* wsl = launder_p(p.ws);
    const bf16_t* P = (const bf16_t*)(wsl + WS_PG); bf16_t* mixed = (bf16_t*)(wsl + WS_Y);
    const int b = item >> 7, rem = item & 127, chunk = rem >> 2, hh = rem & 3;
    const size_t T0 = (size_t)b * SEQ + chunk * 128;
    {
        const int j = tid >> 2, qd = tid & 3;
        const bf16_t* vp = P + (T0 + j) * INW + 512 + 128 * hh + 32 * qd;
        float v[32];
#pragma unroll
        for (int i = 0; i < 4; ++i) { const u32x4 w = *(const u32x4*)(vp + 8 * i);
#pragma unroll
            for (int k = 0; k < 4; ++k) { v[8 * i + 2 * k] = __uint_as_float(w[k] << 16); v[8 * i + 2 * k + 1] = __uint_as_float(w[k] & 0xffff0000u); } }
        float sum = 0.f;
#pragma unroll
        for (int i = 0; i < 32; ++i) sum += v[i];
        sum += __shfl_xor(sum, 1); sum += __shfl_xor(sum, 2);
        const float mu = sum * (1.0f / 128.0f);
        float sq = 0.f;
#pragma unroll
        for (int i = 0; i < 32; ++i) { const float d = v[i] - mu; sq += d * d; }
        sq += __shfl_xor(sq, 1); sq += __shfl_xor(sq, 2);
        const float rstd = rsqrtf(sq * (1.0f / 128.0f) + EPS);
        const float* lg = p.sgu_ln_g + ((size_t)l * 4 + hh) * 128 + 32 * qd; const float* lb = p.sgu_ln_b + ((size_t)l * 4 + hh) * 128 + 32 * qd;
#pragma unroll
        for (int i = 0; i < 32; ++i) { const float o = (v[i] - mu) * rstd * lg[i] + lb[i]; *(LAS bf16_t*)(lds + (32 * qd + i) * 272 + j * 2) = f2bf(o); }
    }
    __syncthreads();
    {
        const int wave = __builtin_amdgcn_readfirstlane(tid >> 6), lane = tid & 63, r = lane & 31, h = lane >> 5;
        const int c0 = 32 * (wave & 3);
        const bf16_t* Wsb = (const bf16_t*)(wsl + WS_SGUW) + ((size_t)l * 4 + hh) * 128 * 128;
#pragma unroll
        for (int q = 0; q < 2; ++q) {
            const int itile = (wave < 4) ? (q ? 3 : 0) : (q ? 2 : 1), i0 = 32 * itile;
            f32x16 acc;
#pragma unroll
            for (int i = 0; i < 16; ++i) acc[i] = 0.f;
            const bf16_t* wrow = Wsb + (size_t)(i0 + r) * 128 + 8 * h;
            const LAS unsigned char* arow = lds + (c0 + r) * 272 + 16 * h;
            for (int ks = 0; ks < 2 * (itile + 1); ++ks) {
                const bf16x8 af = *(const LAS bf16x8*)(arow + ks * 32);
                const bf16x8 bfr = *(const bf16x8*)(wrow + ks * 16);
                acc = MFMA32(af, bfr, acc);
            }
            const float bs = p.sgu_b[((size_t)l * 4 + hh) * 128 + i0 + r];
            const size_t tok = T0 + i0 + r;
#pragma unroll
            for (int g = 0; g < 4; ++g) {
                const int c = c0 + 8 * g + 4 * h;
                const u32x2 uw = *(const u32x2*)(P + tok * INW + 128 * hh + c);
                const float u0 = __uint_as_float(uw.x << 16), u1 = __uint_as_float(uw.x & 0xffff0000u), u2 = __uint_as_float(uw.y << 16), u3 = __uint_as_float(uw.y & 0xffff0000u);
                u32x2 w; w.x = cvt_pk_bf16(u0 * (acc[4 * g] + bs), u1 * (acc[4 * g + 1] + bs)); w.y = cvt_pk_bf16(u2 * (acc[4 * g + 2] + bs), u3 * (acc[4 * g + 3] + bs));
                *(u32x2*)(mixed + tok * DM + 128 * hh + c) = w;
            }
        }
    }
    __syncthreads();
}

constexpr int AT_OPITCH = 136, AT_LSE_OFF = 512 * AT_OPITCH, AT_V_OFF = AT_LSE_OFF + 2048, AT_VPITCH = 144, AT_VBYTES = 32 * AT_VPITCH;
DI void attn_item(const Params& p, int item, LAS unsigned char* lds, int tid) {
    tid = launder_v(tid); unsigned char* wsl = launder_p(p.ws);
    const bf16_t* P = (const bf16_t*)(wsl + WS_PG); bf16_t* mixed = (bf16_t*)(wsl + WS_Y);
    const int wave = __builtin_amdgcn_readfirstlane(tid >> 6), lane = tid & 63, r = lane & 31, h = lane >> 5;
    const int xcd = item & 7, li = item >> 3, bh = (li >> 3) * 8 + xcd, sp = li & 7, b = bh >> 3, hd = bh & 7;
    const bf16_t* Pb = P + (size_t)b * SEQ * INW;
    LAS unsigned char* Ost = lds; LAS float* Lse = (LAS float*)(lds + AT_LSE_OFF); LAS unsigned char* Vst = lds + AT_V_OFF + wave * AT_VBYTES;
    const int vkey = lane >> 1, vhalf = lane & 1;
    const int trq = (lane >> 2) & 3, trp = lane & 3, dhalf = (lane >> 4) & 1;
    const LAS unsigned char* trbase = Vst + (4 * h + trq) * AT_VPITCH + 32 * dhalf + 8 * trp;
    for (int br = 0; br < 3; ++br) {
        const int ldil = 2 * br, dil = 1 << ldil;
        for (int tk = wave; tk < 16; tk += 8) {
            const int res = tk & (dil - 1), qtl = tk >> ldil;
            const int Pq0 = ((sp * 512) >> ldil) + 32 * qtl;
            bf16x8 qf[4];
            { const bf16_t* qp = Pb + (size_t)(res + dil * (Pq0 + r)) * INW + 1024 + 64 * hd + 32 * h;
#pragma unroll
              for (int s = 0; s < 4; ++s) qf[s] = *(const bf16x8*)(qp + 8 * s); }
            f32x16 o0, o1;
#pragma unroll
            for (int i = 0; i < 16; ++i) { o0[i] = 0.f; o1[i] = 0.f; }
            float m = -INFINITY, lsum = 0.f;
            const int kt0 = (Pq0 >= 128) ? -4 : -(Pq0 >> 5);
            bf16x8 kf[4]; u32x4 vr[4];
            { const int P0 = Pq0 + 32 * kt0;
              const bf16_t* kp = Pb + (size_t)(res + dil * (P0 + r)) * INW + 1536 + 64 * hd + 32 * h;
              const bf16_t* vp = Pb + (size_t)(res + dil * (P0 + vkey)) * INW + 2048 + 64 * hd + 32 * vhalf;
#pragma unroll
              for (int s = 0; s < 4; ++s) { kf[s] = *(const bf16x8*)(kp + 8 * s); vr[s] = *(const u32x4*)(vp + 8 * s); } }
            for (int kt = kt0; kt <= 0; ++kt) {
                bf16x8 kn[4]; u32x4 vn[4];
                { const int P0 = Pq0 + 32 * (kt < 0 ? kt + 1 : kt);
                  const bf16_t* kp = Pb + (size_t)(res + dil * (P0 + r)) * INW + 1536 + 64 * hd + 32 * h;
                  const bf16_t* vp = Pb + (size_t)(res + dil * (P0 + vkey)) * INW + 2048 + 64 * hd + 32 * vhalf;
#pragma unroll
                  for (int s = 0; s < 4; ++s) { kn[s] = *(const bf16x8*)(kp + 8 * s); vn[s] = *(const u32x4*)(vp + 8 * s); } }
                f32x16 sc;
#pragma unroll
                for (int i = 0; i < 16; ++i) sc[i] = 0.f;
#pragma unroll
                for (int s = 0; s < 4; ++s) sc = MFMA32(kf[s], qf[s], sc);
                if (kt == -4) {
#pragma unroll
                    for (int i = 0; i < 16; ++i) { const int kk = 8 * (i >> 2) + 4 * h + (i & 3); if (kk < r) sc[i] = -INFINITY; }
                }
                if (kt == 0) {
#pragma unroll
                    for (int i = 0; i < 16; ++i) { const int kk = 8 * (i >> 2) + 4 * h + (i & 3); if (kk > r) sc[i] = -INFINITY; }
                }
                float tmax = sc[0];
#pragma unroll
                for (int i = 1; i < 16; ++i) tmax = fmaxf(tmax, sc[i]);
                tmax = fmaxf(tmax, __shfl_xor(tmax, 32));
                const float mnew = fmaxf(m, tmax), alpha = fast_exp2(m - mnew);
                m = mnew;
                float psum = 0.f;
#pragma unroll
                for (int i = 0; i < 16; ++i) { sc[i] = fast_exp2(sc[i] - mnew); psum += sc[i]; }
                lsum = lsum * alpha + psum;
#pragma unroll
                for (int i = 0; i < 16; ++i) { o0[i] *= alpha; o1[i] *= alpha; }
#pragma unroll
                for (int s = 0; s < 4; ++s) *(LAS u32x4*)(Vst + vkey * AT_VPITCH + 64 * vhalf + 16 * s) = vr[s];
                asm volatile("" ::: "memory");
                const bf16x8 pb0 = pack8(sc, 0), pb1 = pack8(sc, 1);
#pragma unroll
                for (int s2 = 0; s2 < 2; ++s2) {
#pragma unroll
                    for (int dt = 0; dt < 2; ++dt) {
                        const s16x4 lo = __builtin_amdgcn_ds_read_tr16_b64_v4i16((LAS s16x4*)(trbase + (16 * s2) * AT_VPITCH + 64 * dt));
                        const s16x4 hi = __builtin_amdgcn_ds_read_tr16_b64_v4i16((LAS s16x4*)(trbase + (16 * s2 + 8) * AT_VPITCH + 64 * dt));
                        const bf16x8 vf = __builtin_shufflevector(lo, hi, 0, 1, 2, 3, 4, 5, 6, 7);
                        if (dt == 0) o0 = MFMA32(vf, s2 ? pb1 : pb0, o0); else o1 = MFMA32(vf, s2 ? pb1 : pb0, o1);
                    }
                }
                asm volatile("" ::: "memory");
#pragma unroll
                for (int s = 0; s < 4; ++s) { kf[s] = kn[s]; vr[s] = vn[s]; }
            }
            const float ltot = lsum + __shfl_xor(lsum, 32);
            float lse = m + __builtin_amdgcn_logf(ltot);
            float fn = fast_rcp(ltot), fp = 0.f;
            const int tl = res + dil * (32 * qtl + r);
            LAS unsigned char* orow = Ost + tl * AT_OPITCH + 8 * h;
            if (br > 0) {
                const float lp = Lse[tl], mx = fmaxf(lp, lse), wp = fast_exp2(lp - mx), wn = fast_exp2(lse - mx), den = wp + wn, iden = fast_rcp(den);
                fp = wp * iden; fn = fn * wn * iden; lse = mx + __builtin_amdgcn_logf(den);
            }
            if (br < 2) { if (h == 0) Lse[tl] = lse; }
            bf16_t* grow = mixed + ((size_t)b * SEQ + sp * 512 + tl) * DM + 512 + 64 * hd + 4 * h;
#pragma unroll
            for (int dt = 0; dt < 2; ++dt)
#pragma unroll
                for (int g = 0; g < 4; ++g) {
                    float v0 = (dt ? o1 : o0)[4 * g] * fn, v1 = (dt ? o1 : o0)[4 * g + 1] * fn, v2 = (dt ? o1 : o0)[4 * g + 2] * fn, v3 = (dt ? o1 : o0)[4 * g + 3] * fn;
                    if (br > 0) { const u32x2 pw = *(const LAS u32x2*)(orow + 64 * dt + 16 * g);
                        v0 += fp * __uint_as_float(pw.x << 16); v1 += fp * __uint_as_float(pw.x & 0xffff0000u); v2 += fp * __uint_as_float(pw.y << 16); v3 += fp * __uint_as_float(pw.y & 0xffff0000u); }
                    u32x2 w; w.x = cvt_pk_bf16(v0, v1); w.y = cvt_pk_bf16(v2, v3);
                    if (br < 2) *(LAS u32x2*)(orow + 64 * dt + 16 * g) = w; else *(u32x2*)(grow + 32 * dt + 8 * g) = w;
                }
        }
        __syncthreads();
    }
}

__global__ void __launch_bounds__(NTHR, 2) fwd_megakernel(Params p) {
    extern __shared__ __attribute__((aligned(16))) unsigned char smem[];
    LAS unsigned char* lds = (LAS unsigned char*)smem;
    cg::grid_group grid = cg::this_grid();
    const int tid = threadIdx.x;
    unsigned char* ws = p.ws;

    prelude_phase(p, lds, tid);
    grid.sync();

    for (int l = 0; l < 2; ++l) {
        for (int sb = 0; sb < 3; ++sb) {
            ws = launder_p(ws);
            const float* modl = (const float*)(ws + WS_MOD) + (size_t)l * 8 * (NADA * DM);
            bf16_t* Y = (bf16_t*)(ws + WS_Y); bf16_t* PG = (bf16_t*)(ws + WS_PG);
            const float* hin = (l == 0 && sb == 0) ? p.x : p.out;
            norm_phase(hin, p.norm_g + ((size_t)l * 3 + sb) * DM, modl + (3 * sb) * DM, modl + (3 * sb + 1) * DM, Y, tid);
            grid.sync();
            const bf16_t* A2; const bf16_t* B2; int K2; float gsc;
            if (sb != 1) {
                const int lf = l * 2 + (sb >> 1);
                pg8::Gemm g{Y, (const bf16_t*)(ws + WS_UP + (size_t)lf * SZ_UP), MTOK, 2 * FF, DM};
                pg8::StaticOrder S; S.init(MTOK, 2 * FF, (int)gridDim.x, (int)blockIdx.x);
                EpiSwiglu E{PG};
                pg8::gemm_phase<EpiSwiglu>(lds, g, S, E);
                grid.sync();
                A2 = PG; B2 = (const bf16_t*)(ws + WS_DN + (size_t)lf * SZ_DN); K2 = FF; gsc = 0.5f;
            } else {
                pg8::Gemm g{Y, (const bf16_t*)(ws + WS_IN + (size_t)l * SZ_IN), MTOK, INW, DM};
                pg8::StaticOrder S; S.init(MTOK, INW, (int)gridDim.x, (int)blockIdx.x);
                EpiIn E{PG, (const float*)(ws + WS_ROPE)};
                pg8::gemm_phase<EpiIn>(lds, g, S, E);
                grid.sync();
                for (int it = blockIdx.x; it < 1024; it += gridDim.x) sgu_item(p, l, it, lds, tid);
                for (int it = blockIdx.x; it < 512; it += gridDim.x) attn_item(p, it, lds, tid);
                grid.sync();
                A2 = Y; B2 = (const bf16_t*)(ws + WS_OUT + (size_t)l * SZ_OUT); K2 = DM; gsc = 1.0f;
            }
            {
                pg8::Gemm g{A2, B2, MTOK, DM, K2};
                pg8::StaticOrder S; S.init(MTOK, DM, (int)gridDim.x, (int)blockIdx.x);
                EpiResid E{hin, p.out, modl + (3 * sb + 2) * DM, gsc};
                pg8::gemm_phase<EpiResid>(lds, g, S, E);
                grid.sync();
            }
        }
    }
    final_norm_phase(p.out, p.final_g, tid);
}

constexpr int LDS_BYTES = 131072;
extern "C" void kernel_launch(void* const* d_in, const int* in_sizes, int n_in, void* d_out, int out_size, void* d_ws, size_t ws_size, hipStream_t stream) {
    static int grid_blocks = 0;
    if (!grid_blocks) {
        int dev = 0, cus = 0, per_cu = 0;
        hipGetDevice(&dev);
        hipDeviceGetAttribute(&cus, hipDeviceAttributeMultiprocessorCount, dev);
        hipFuncSetAttribute((const void*)fwd_megakernel, hipFuncAttributeMaxDynamicSharedMemorySize, LDS_BYTES);
        hipOccupancyMaxActiveBlocksPerMultiprocessor(&per_cu, (const void*)fwd_megakernel, NTHR, LDS_BYTES);
        if (per_cu < 1) per_cu = 1;
        grid_blocks = cus * per_cu;
        if (ws_size < WS_END) fprintf(stderr, "kernel_launch: workspace too small (%zu < %zu)\n", ws_size, (size_t)WS_END);
    }
    Params p{};
    p.x = (const float*)d_in[0]; p.c = (const float*)d_in[1]; p.ada_w = (const float*)d_in[2]; p.ada_b = (const float*)d_in[3]; p.norm_g = (const float*)d_in[4];
    p.f1g = (const float*)d_in[5]; p.f1u = (const float*)d_in[6]; p.f1d = (const float*)d_in[7]; p.f2g = (const float*)d_in[8]; p.f2u = (const float*)d_in[9]; p.f2d = (const float*)d_in[10];
    p.w_in = (const float*)d_in[11]; p.sgu_ln_g = (const float*)d_in[12]; p.sgu_ln_b = (const float*)d_in[13]; p.sgu_w = (const float*)d_in[14]; p.sgu_b = (const float*)d_in[15];
    p.w_out = (const float*)d_in[16]; p.final_g = (const float*)d_in[17];
    p.out = (float*)d_out; p.ws = (unsigned char*)d_ws;
    void* args[] = {&p};
    hipError_t e = hipLaunchCooperativeKernel((const void*)fwd_megakernel, dim3(grid_blocks), dim3(NTHR), args, LDS_BYTES, stream);
    if (e != hipSuccess) fprintf(stderr, "cooperative launch failed: %s (grid %d)\n", hipGetErrorString(e), grid_blocks);
}
```

```cpp
#include <hip/hip_runtime.h>
#include <hip/hip_cooperative_groups.h>
#include <cstdio>
namespace cg = cooperative_groups;

#define LAS __attribute__((address_space(3)))
#define DI __device__ __forceinline__
typedef unsigned short bf16_t;
typedef short bf16x8 __attribute__((ext_vector_type(8)));
typedef short s16x4 __attribute__((ext_vector_type(4)));
typedef float f32x4 __attribute__((ext_vector_type(4)));
typedef float f32x2 __attribute__((ext_vector_type(2)));
typedef float f32x16 __attribute__((ext_vector_type(16)));
typedef unsigned u32x4 __attribute__((ext_vector_type(4)));
typedef unsigned u32x2 __attribute__((ext_vector_type(2)));

constexpr int DM = 1024, NB = 8, SEQ = 4096, MTOK = NB * SEQ, FF = 2816, INW = 2560, NADA = 9;
constexpr int NTHR = 512;
constexpr float EPS = 1e-6f;

constexpr size_t SZ_UP = (size_t)2 * FF * DM * 2;
constexpr size_t SZ_DN = (size_t)DM * FF * 2;
constexpr size_t SZ_IN = (size_t)INW * DM * 2;
constexpr size_t SZ_OUT = (size_t)DM * DM * 2;
constexpr size_t WS_UP = 0;
constexpr size_t WS_DN = WS_UP + 4 * SZ_UP;
constexpr size_t WS_IN = WS_DN + 4 * SZ_DN;
constexpr size_t WS_OUT = WS_IN + 2 * SZ_IN;
constexpr size_t WS_SGUW = WS_OUT + 2 * SZ_OUT;
constexpr size_t WS_MOD = WS_SGUW + (size_t)2 * 4 * 128 * 128 * 2;
constexpr size_t WS_ROPE = WS_MOD + (size_t)2 * 8 * 9216 * 4;
constexpr size_t WS_Y = WS_ROPE + (size_t)4096 * 32 * 8;
constexpr size_t WS_PG = WS_Y + (size_t)MTOK * DM * 2;
constexpr size_t WS_BAR = WS_PG + (size_t)MTOK * FF * 2;
constexpr size_t WS_END = WS_BAR + 16384;

struct Params {
    const float *x, *c, *ada_w, *ada_b, *norm_g, *f1g, *f1u, *f1d, *f2g, *f2u, *f2d, *w_in, *sgu_ln_g, *sgu_ln_b, *sgu_w, *sgu_b, *w_out, *final_g;
    float* out; unsigned char* ws;
};

DI int launder_v(int x) { asm volatile("" : "+v"(x)); return x; }
template <class T> DI T* launder_p(T* q) { asm volatile("" : "+s"(q)); return q; }
DI float bf2f(unsigned short v) { return __uint_as_float((unsigned)v << 16); }
DI unsigned short f2bf(float f) { unsigned u = __float_as_uint(f); u += 0x7fffu + ((u >> 16) & 1u); return (unsigned short)(u >> 16); }
DI unsigned cvt_pk_bf16(float lo, float hi) { unsigned r; asm("v_cvt_pk_bf16_f32 %0, %1, %2" : "=v"(r) : "v"(lo), "v"(hi)); return r; }
DI float fast_exp2(float x) { return __builtin_amdgcn_exp2f(x); }
DI float fast_rcp(float x) { return __builtin_amdgcn_rcpf(x); }
DI float silu_f(float x) { return x * fast_rcp(1.0f + fast_exp2(-1.4426950409f * x)); }
DI float gelu_tanh_f(float x) { const float t = 0.7978845608f * (x + 0.044715f * x * x * x); return x * fast_rcp(1.0f + fast_exp2(-2.8853900818f * t)); }

namespace pg8 {
constexpr int BM = 256, BK = 64, HALF = 128, HTB = HALF * BK * 2, STAGE_BYTES = 8 * HTB, NXCD = 8, WGM = 8;
DI int lds_byte(int r, int c) { const int st = (r >> 4) * 2 + (c >> 5), rr = r & 15, cc = c & 31, ob = rr * 64 + cc * 2; return st * 1024 + (ob ^ (((ob >> 9) & 1) << 5)); }
DI void stage_rc(int b, int& R, int& C) { const int st = b / 1024, sb = b % 1024, swz = sb ^ (((sb >> 9) & 1) << 5); R = (st >> 1) * 16 + swz / 64; C = (st & 1) * 32 + (swz % 64) / 2; }
DI int perm32(int rho) { const int n = rho >> 4, i = rho & 15; return 8 * (i >> 2) + 4 * n + (i & 3); }
struct Unit { int pm, pn; };
struct Gemm { const bf16_t* A; const bf16_t* Bt; int M, N, K; };
struct StaticOrder {
    int nM, nN, nwg, G, c;
    DI void init(int M, int N, int G_, int c_) { nM = M / BM; nN = N / BM; nwg = nM * nN; G = G_; c = c_; }
    DI bool next(int i, Unit& u) const {
        const long L = (long)i * G + c; if (L >= nwg) return false;
        int wgid = (int)L; { const int q = nwg / NXCD, r = nwg % NXCD, xcd = wgid % NXCD, off = wgid / NXCD; wgid = (xcd < r ? xcd * (q + 1) : r * (q + 1) + (xcd - r) * q) + off; }
        const int nig = WGM * nN, gid = wgid / nig, fm = gid * WGM, gsz = (nM - fm) < WGM ? (nM - fm) : WGM;
        u.pm = fm + ((wgid % nig) % gsz); u.pn = (wgid % nig) / gsz; return true;
    }
};

template <class Epi>
DI void gemm_phase(LAS unsigned char* lds, const Gemm g, const StaticOrder& S, const Epi& E) {
    const int tid = launder_v(threadIdx.x), wid = __builtin_amdgcn_readfirstlane(tid >> 6), lane = tid & 63, wr = wid >> 2, wc = wid & 3, fr = lane & 15, fq = lane >> 4;
    const int K = g.K, nt = K / BK;
    unsigned voffA[2], voffB[2];
#pragma unroll
    for (int i = 0; i < 2; ++i) { int R, C; stage_rc(tid * 16 + i * 8192, R, C); const int Rb = Epi::PERM ? ((R & ~31) + perm32(R & 31)) : R;
        voffA[i] = (unsigned)(R * K + C) * 2u; voffB[i] = (unsigned)(Rb * K + C) * 2u; }
    const size_t kstep = (size_t)(BK * 2);
    const size_t hstep = (size_t)HALF * K * 2;
    const size_t tstep = 2 * hstep;
    const unsigned ldsw = (unsigned)wid * 1024u;
    const int aoff = lds_byte(wr * 64 + fr, fq * 8), boff = lds_byte(wc * 32 + fr, fq * 8);
#define PG8_SA(b, h) (((b) * 2 + (h)) * HTB)
#define PG8_SB(b, h) ((4 + (b) * 2 + (h)) * HTB)
#define PG8_STAGE(bufoff, gbase, voff) do { _Pragma("unroll") for (int _i = 0; _i < 2; ++_i) \
        __builtin_amdgcn_global_load_lds((const unsigned*)((const char*)(gbase) + (voff)[_i]), (LAS unsigned*)(lds + (bufoff) + ldsw + _i * 8192), 16, 0, 0); } while (0)
#define PG8_LDA(dst, b, h) do { _Pragma("unroll") for (int m = 0; m < 4; ++m) _Pragma("unroll") for (int k = 0; k < 2; ++k) dst[m][k] = *(const LAS bf16x8*)(lds + PG8_SA(b, h) + aoff + m * 2048 + k * 1024); } while (0)
#define PG8_LDB(dst, b, h) do { _Pragma("unroll") for (int n = 0; n < 2; ++n) _Pragma("unroll") for (int k = 0; k < 2; ++k) dst[n][k] = *(const LAS bf16x8*)(lds + PG8_SB(b, h) + boff + n * 2048 + k * 1024); } while (0)
#define PG8_MMA(ai, bj, At, Bt) do { __builtin_amdgcn_s_setprio(1); _Pragma("unroll") for (int m = 0; m < 4; ++m) _Pragma("unroll") for (int n = 0; n < 2; ++n) _Pragma("unroll") for (int k = 0; k < 2; ++k) \
        acc[ai][bj][m][n] = __builtin_amdgcn_mfma_f32_16x16x32_bf16(Bt[n][k], At[m][k], acc[ai][bj][m][n], 0, 0, 0); __builtin_amdgcn_s_setprio(0); } while (0)
#define PG8_WAIT_V(n) asm volatile("s_waitcnt vmcnt(" #n ")" ::: "memory")
#define PG8_WAIT_L(n) asm volatile("s_waitcnt lgkmcnt(" #n ")" ::: "memory")
#define PG8_BAR __builtin_amdgcn_s_barrier()
#define PG8_SCHED __builtin_amdgcn_sched_barrier(0)
    Unit cur, nxt; int ui = 0;
    if (!S.next(0, cur)) return;
    f32x4 acc[2][2][4][2];
#pragma unroll
    for (int a = 0; a < 2; ++a)
#pragma unroll
        for (int b = 0; b < 2; ++b)
#pragma unroll
            for (int m = 0; m < 4; ++m)
#pragma unroll
                for (int n = 0; n < 2; ++n) acc[a][b][m][n] = (f32x4){0.f, 0.f, 0.f, 0.f};
    bf16x8 At[4][2], B0[2][2], B1[2][2];
    const char* cA = (const char*)g.A + (size_t)cur.pm * tstep; const char* cB = (const char*)g.Bt + (size_t)cur.pn * tstep;
    PG8_STAGE(PG8_SB(0, 0), cB, voffB); PG8_STAGE(PG8_SA(0, 0), cA, voffA); PG8_STAGE(PG8_SB(0, 1), cB + hstep, voffB); PG8_STAGE(PG8_SA(0, 1), cA + hstep, voffA);
    if (wr == 1) PG8_BAR;
    PG8_WAIT_V(4); PG8_BAR;
    PG8_STAGE(PG8_SB(1, 0), cB + kstep, voffB); PG8_STAGE(PG8_SA(1, 0), cA + kstep, voffA); PG8_STAGE(PG8_SB(1, 1), cB + hstep + kstep, voffB);
    PG8_WAIT_V(6); PG8_BAR;
    for (;;) {
        const bool has_next = S.next(ui + 1, nxt);
        const char* nA = has_next ? (const char*)g.A + (size_t)nxt.pm * tstep : cA; const char* nB = has_next ? (const char*)g.Bt + (size_t)nxt.pn * tstep : cB;
        for (int t = 0; t < nt; t += 2) {
            const bool last = (t == nt - 2);
            const char* a1 = cA + (size_t)(t + 1) * kstep;
            const char* a2 = last ? nA : cA + (size_t)(t + 2) * kstep; const char* b2 = last ? nB : cB + (size_t)(t + 2) * kstep;
            const char* a3 = a2 + kstep; const char* b3 = b2 + kstep;
            PG8_LDB(B0, 0, 0); PG8_SCHED; PG8_LDA(At, 0, 0); PG8_STAGE(PG8_SA(1, 1), a1 + hstep, voffA);
            PG8_WAIT_L(8); PG8_BAR; PG8_WAIT_L(0); PG8_MMA(0, 0, At, B0); PG8_BAR; PG8_SCHED;
            PG8_LDB(B1, 0, 1); PG8_STAGE(PG8_SB(0, 0), b2, voffB);
            PG8_BAR; PG8_WAIT_L(0); PG8_MMA(0, 1, At, B1); PG8_BAR;
            PG8_LDA(At, 0, 1); PG8_STAGE(PG8_SA(0, 0), a2, voffA);
            PG8_BAR; PG8_WAIT_L(0); PG8_MMA(1, 0, At, B0); PG8_BAR; PG8_SCHED;
            PG8_STAGE(PG8_SB(0, 1), b2 + hstep, voffB);
            PG8_WAIT_V(6); PG8_BAR; PG8_MMA(1, 1, At, B1); PG8_BAR;
            PG8_LDB(B0, 1, 0); PG8_SCHED; PG8_LDA(At, 1, 0); PG8_STAGE(PG8_SA(0, 1), a2 + hstep, voffA);
            PG8_WAIT_L(8); PG8_BAR; PG8_WAIT_L(0); PG8_MMA(0, 0, At, B0); PG8_BAR; PG8_SCHED;
            PG8_LDB(B1, 1, 1); PG8_STAGE(PG8_SB(1, 0), b3, voffB);
            PG8_BAR; PG8_WAIT_L(0); PG8_MMA(0, 1, At, B1); PG8_BAR;
            PG8_LDA(At, 1, 1); PG8_STAGE(PG8_SA(1, 0), a3, voffA);
            PG8_BAR; PG8_WAIT_L(0); PG8_MMA(1, 0, At, B0); PG8_BAR; PG8_SCHED;
            PG8_STAGE(PG8_SB(1, 1), b3 + hstep, voffB);
            PG8_WAIT_V(6); PG8_BAR; PG8_MMA(1, 1, At, B1); PG8_BAR;
        }
        E(acc, cur, wr, wc, fr, fq);
        if (!has_next) break;
#pragma unroll
        for (int a = 0; a < 2; ++a)
#pragma unroll
            for (int b = 0; b < 2; ++b)
#pragma unroll
                for (int m = 0; m < 4; ++m)
#pragma unroll
                    for (int n = 0; n < 2; ++n) acc[a][b][m][n] = (f32x4){0.f, 0.f, 0.f, 0.f};
        cur = nxt; cA = nA; cB = nB; ++ui;
    }
    PG8_WAIT_V(0);
    if (wr == 0) PG8_BAR;
    PG8_BAR;
#undef PG8_SA
#undef PG8_SB
#undef PG8_STAGE
#undef PG8_LDA
#undef PG8_LDB
#undef PG8_MMA
#undef PG8_WAIT_V
#undef PG8_WAIT_L
#undef PG8_BAR
#undef PG8_SCHED
}
}

struct EpiSwiglu {
    static constexpr bool PERM = true;
    bf16_t* G;
    DI void operator()(const f32x4 (&acc)[2][2][4][2], const pg8::Unit& u, int wr, int wc, int fr, int fq) const {
        const int row0 = u.pm * 256 + wr * 64 + fr, col0 = u.pn * 128 + wc * 32 + 8 * fq;
#pragma unroll
        for (int ai = 0; ai < 2; ++ai)
#pragma unroll
            for (int m = 0; m < 4; ++m) {
                bf16_t* rowp = G + (size_t)(row0 + ai * 128 + m * 16) * FF + col0;
                const f32x4 g0 = acc[ai][0][m][0], g1 = acc[ai][0][m][1], u0 = acc[ai][1][m][0], u1 = acc[ai][1][m][1];
                u32x4 w;
                w.x = cvt_pk_bf16(silu_f(g0[0]) * u0[0], silu_f(g0[1]) * u0[1]); w.y = cvt_pk_bf16(silu_f(g0[2]) * u0[2], silu_f(g0[3]) * u0[3]);
                w.z = cvt_pk_bf16(silu_f(g1[0]) * u1[0], silu_f(g1[1]) * u1[1]); w.w = cvt_pk_bf16(silu_f(g1[2]) * u1[2], silu_f(g1[3]) * u1[3]);
                *(u32x4*)rowp = w;
            }
    }
};
struct EpiResid {
    static constexpr bool PERM = false;
    const float* hin; float* hout; const float* gate; float gscale;
    DI void operator()(const f32x4 (&acc)[2][2][4][2], const pg8::Unit& u, int wr, int wc, int fr, int fq) const {
        const int row0 = u.pm * 256 + wr * 64 + fr, col0 = u.pn * 256 + wc * 32 + 4 * fq, b = (u.pm * 256) / SEQ;
        f32x4 gv[2][2];
#pragma unroll
        for (int bj = 0; bj < 2; ++bj)
#pragma unroll
            for (int n = 0; n < 2; ++n) gv[bj][n] = *(const f32x4*)(gate + (size_t)b * (NADA * DM) + col0 + bj * 128 + n * 16) * gscale;
#pragma unroll
        for (int ai = 0; ai < 2; ++ai)
#pragma unroll
            for (int m = 0; m < 4; ++m) {
                const size_t off = (size_t)(row0 + ai * 128 + m * 16) * DM + col0;
#pragma unroll
                for (int bj = 0; bj < 2; ++bj)
#pragma unroll
                    for (int n = 0; n < 2; ++n) {
                        const f32x4 hv = *(const f32x4*)(hin + off + bj * 128 + n * 16);
                        *(f32x4*)(hout + off + bj * 128 + n * 16) = hv + gv[bj][n] * acc[ai][bj][m][n];
                    }
            }
    }
};
struct EpiIn {
    static constexpr bool PERM = true;
    bf16_t* P; const float* rope;
    DI void operator()(const f32x4 (&acc)[2][2][4][2], const pg8::Unit& u, int wr, int wc, int fr, int fq) const {
        const int row0 = u.pm * 256 + wr * 64 + fr, col0 = u.pn * 256 + wc * 32 + 8 * fq, kind = u.pn >> 1;
        const int i0 = 16 * (wc & 1) + 4 * fq;
        const float qs = (kind == 2) ? 0.125f * 1.4426950409f : 1.0f;
#pragma unroll
        for (int ai = 0; ai < 2; ++ai)
#pragma unroll
            for (int m = 0; m < 4; ++m) {
                const int row = row0 + ai * 128 + m * 16, pos = row & (SEQ - 1);
                bf16_t* rowp = P + (size_t)row * INW + col0;
                f32x4 cs0 = {1.f, 0.f, 1.f, 0.f}, cs1 = {1.f, 0.f, 1.f, 0.f};
                if (kind == 2 || kind == 3) { const f32x4* rp = (const f32x4*)(rope + ((size_t)pos * 32 + i0) * 2); cs0 = rp[0]; cs1 = rp[1]; }
#pragma unroll
                for (int bj = 0; bj < 2; ++bj) {
                    f32x4 v0 = acc[ai][bj][m][0], v1 = acc[ai][bj][m][1];
                    if (kind <= 1) {
#pragma unroll
                        for (int j = 0; j < 4; ++j) { v0[j] = gelu_tanh_f(v0[j]); v1[j] = gelu_tanh_f(v1[j]); }
                    } else if (kind <= 3) {
                        const float c[4] = {cs0[0], cs0[2], cs1[0], cs1[2]}, s[4] = {cs0[1], cs0[3], cs1[1], cs1[3]};
#pragma unroll
                        for (int j = 0; j < 4; ++j) { const float x1 = v0[j], x2 = v1[j]; v0[j] = (x1 * c[j] - x2 * s[j]) * qs; v1[j] = (x2 * c[j] + x1 * s[j]) * qs; }
                    }
                    u32x4 w; w.x = cvt_pk_bf16(v0[0], v0[1]); w.y = cvt_pk_bf16(v0[2], v0[3]); w.z = cvt_pk_bf16(v1[0], v1[1]); w.w = cvt_pk_bf16(v1[2], v1[3]);
                    *(u32x4*)(rowp + bj * 128) = w;
                }
            }
    }
};

DI void tr_tile(const float* src, int ld_src, int srccol0, int k0, bf16_t* dst, int ld_dst, int n0, bool rperm, LAS float* tile, int tid) {
#pragma unroll
    for (int i = 0; i < 2; ++i) {
        const int idx = tid + i * NTHR, row = idx >> 4, c4 = idx & 15;
        const f32x4 v = *(const f32x4*)(src + (size_t)(k0 + row) * ld_src + srccol0 + c4 * 4);
        LAS float* t = tile + row * 65 + c4 * 4; t[0] = v[0]; t[1] = v[1]; t[2] = v[2]; t[3] = v[3];
    }
    __syncthreads();
    const int p = tid >> 3, kc = (tid & 7) * 8;
    const int pp = rperm ? (4 * (p >> 3) + (p & 3) + 32 * ((p >> 2) & 1)) : p;
    float v[8];
#pragma unroll
    for (int j = 0; j < 8; ++j) v[j] = tile[(kc + j) * 65 + pp];
    u32x4 w; w.x = cvt_pk_bf16(v[0], v[1]); w.y = cvt_pk_bf16(v[2], v[3]); w.z = cvt_pk_bf16(v[4], v[5]); w.w = cvt_pk_bf16(v[6], v[7]);
    *(u32x4*)(dst + (size_t)(n0 + p) * ld_dst + k0 + kc) = w;
    __syncthreads();
}

constexpr int IT_MOD = 288;
constexpr int IT_ROPE = 256, IT_SGUW = 256;
constexpr int T_UP = 88 * 16, T_DN = 16 * 44, T_IN = 40 * 16, T_OUT = 16 * 16;
constexpr int IT_UP0 = IT_MOD + IT_ROPE + IT_SGUW, IT_DN0 = IT_UP0 + 4 * T_UP, IT_IN0 = IT_DN0 + 4 * T_DN, IT_OUT0 = IT_IN0 + 2 * T_IN, IT_END = IT_OUT0 + 2 * T_OUT;

DI void prelude_phase(const Params& p, LAS unsigned char* lds, int tid) {
    unsigned char* ws = p.ws;
    for (int it = blockIdx.x; it < IT_END; it += gridDim.x) {
        if (it < IT_MOD) {
            const int l = it / 144, cb = it % 144;
            LAS float* s = (LAS float*)lds; LAS float* red = (LAS float*)(lds + 32768);
            for (int i = tid; i < NB * DM; i += NTHR) s[i] = silu_f(p.c[i]);
            __syncthreads();
            const int cp = tid & 31, kg = tid >> 5;
            float a[8][2];
#pragma unroll
            for (int b = 0; b < 8; ++b) { a[b][0] = 0.f; a[b][1] = 0.f; }
            const float* w = p.ada_w + (size_t)l * DM * (NADA * DM) + (size_t)(kg * 64) * (NADA * DM) + cb * 64 + cp * 2;
#pragma unroll 4
            for (int k = 0; k < 64; ++k) {
                const f32x2 wv = *(const f32x2*)(w + (size_t)k * (NADA * DM));
#pragma unroll
                for (int b = 0; b < 8; ++b) { const float sv = s[b * DM + kg * 64 + k]; a[b][0] += sv * wv.x; a[b][1] += sv * wv.y; }
            }
#pragma unroll
            for (int b = 0; b < 8; ++b) { red[(kg * 8 + b) * 64 + cp * 2] = a[b][0]; red[(kg * 8 + b) * 64 + cp * 2 + 1] = a[b][1]; }
            __syncthreads();
            { const int b = tid >> 6, col = tid & 63; float sum = 0.f;
#pragma unroll
              for (int g = 0; g < 16; ++g) sum += red[(g * 8 + b) * 64 + col];
              const int n = cb * 64 + col;
              ((float*)(ws + WS_MOD))[((size_t)l * 8 + b) * (NADA * DM) + n] = sum + p.ada_b[(size_t)l * (NADA * DM) + n]; }
            __syncthreads();
        } else if (it < IT_MOD + IT_ROPE) {
            const int idx = (it - IT_MOD) * NTHR + tid, pos = idx >> 5, i = idx & 31;
            const float inv = exp2f(-(float)i * (13.287712379549449f / 32.0f));
            const float ang = (float)pos * inv;
            const double rev = (double)ang * 0.15915494309189535;
            const float fr = (float)(rev - floor(rev));
            f32x2 cs; cs.x = __builtin_amdgcn_cosf(fr); cs.y = __builtin_amdgcn_sinf(fr);
            ((f32x2*)(ws + WS_ROPE))[idx] = cs;
        } else if (it < IT_UP0) {
            const int idx = (it - IT_MOD - IT_ROPE) * NTHR + tid, j = idx & 127, i = (idx >> 7) & 127;
            ((bf16_t*)(ws + WS_SGUW))[idx] = (j <= i) ? f2bf(p.sgu_w[idx]) : (bf16_t)0;
        } else if (it < IT_DN0) {
            const int r = it - IT_UP0, lf = r / T_UP, t = r % T_UP, nb = t >> 4, kb = t & 15, l = lf >> 1, f = lf & 1;
            const int n0 = nb * 64, tl = n0 >> 8, half = (n0 >> 7) & 1, j0 = n0 & 127;
            const float* src = (f ? (half ? p.f2u : p.f2g) : (half ? p.f1u : p.f1g)) + (size_t)l * DM * FF;
            tr_tile(src, FF, tl * 128 + j0, kb * 64, (bf16_t*)(ws + WS_UP + (size_t)lf * SZ_UP), DM, n0, false, (LAS float*)lds, tid);
        } else if (it < IT_IN0) {
            const int r = it - IT_DN0, lf = r / T_DN, t = r % T_DN, nb = t / 44, kb = t % 44, l = lf >> 1, f = lf & 1;
            const float* src = (f ? p.f2d : p.f1d) + (size_t)l * FF * DM;
            tr_tile(src, DM, nb * 64, kb * 64, (bf16_t*)(ws + WS_DN + (size_t)lf * SZ_DN), FF, nb * 64, false, (LAS float*)lds, tid);
        } else if (it < IT_OUT0) {
            const int r = it - IT_IN0, l = r / T_IN, t = r % T_IN, nb = t >> 4, kb = t & 15, n0 = nb * 64;
            tr_tile(p.w_in + (size_t)l * DM * INW, INW, n0, kb * 64, (bf16_t*)(ws + WS_IN + (size_t)l * SZ_IN), DM, n0, (n0 >= 1024 && n0 < 2048), (LAS float*)lds, tid);
        } else {
            const int r = it - IT_OUT0, l = r / T_OUT, t = r % T_OUT, nb = t >> 4, kb = t & 15;
            tr_tile(p.w_out + (size_t)l * DM * DM, DM, nb * 64, kb * 64, (bf16_t*)(ws + WS_OUT + (size_t)l * SZ_OUT), DM, nb * 64, false, (LAS float*)lds, tid);
        }
    }
}

DI float wave_sum(float v) {
#pragma unroll
    for (int o = 32; o >= 1; o >>= 1) v += __shfl_xor(v, o);
    return v;
}
DI void norm_phase(const float* h, const float* g, const float* sh, const float* sc, bf16_t* y, int tid) {
    tid = launder_v(tid);
    const int wave = tid >> 6, lane = tid & 63;
    for (int row = blockIdx.x * 8 + wave; row < MTOK; row += gridDim.x * 8) {
        const int b = row / SEQ;
        const float* hp = h + (size_t)row * DM;
        f32x4 v[4]; float ss = 0.f;
#pragma unroll
        for (int i = 0; i < 4; ++i) { v[i] = *(const f32x4*)(hp + i * 256 + lane * 4); ss += v[i][0] * v[i][0] + v[i][1] * v[i][1] + v[i][2] * v[i][2] + v[i][3] * v[i][3]; }
        ss = wave_sum(ss);
        const float rstd = rsqrtf(ss * (1.0f / DM) + EPS);
#pragma unroll
        for (int i = 0; i < 4; ++i) {
            const int col = i * 256 + lane * 4;
            const f32x4 gv = *(const f32x4*)(g + col), sv = *(const f32x4*)(sc + (size_t)b * (NADA * DM) + col), hv = *(const f32x4*)(sh + (size_t)b * (NADA * DM) + col);
            float o[4];
#pragma unroll
            for (int j = 0; j < 4; ++j) o[j] = v[i][j] * rstd * gv[j] * (1.0f + sv[j]) + hv[j];
            u32x2 w; w.x = cvt_pk_bf16(o[0], o[1]); w.y = cvt_pk_bf16(o[2], o[3]);
            *(u32x2*)(y + (size_t)row * DM + col) = w;
        }
    }
}
DI void final_norm_phase(float* h, const float* g, int tid) {
    const int wave = tid >> 6, lane = tid & 63;
    for (int row = blockIdx.x * 8 + wave; row < MTOK; row += gridDim.x * 8) {
        float* hp = h + (size_t)row * DM;
        f32x4 v[4]; float ss = 0.f;
#pragma unroll
        for (int i = 0; i < 4; ++i) { v[i] = *(const f32x4*)(hp + i * 256 + lane * 4); ss += v[i][0] * v[i][0] + v[i][1] * v[i][1] + v[i][2] * v[i][2] + v[i][3] * v[i][3]; }
        ss = wave_sum(ss);
        const float rstd = rsqrtf(ss * (1.0f / DM) + EPS);
#pragma unroll
        for (int i = 0; i < 4; ++i) { const int col = i * 256 + lane * 4; const f32x4 gv = *(const f32x4*)(g + col); *(f32x4*)(hp + col) = v[i] * rstd * gv; }
    }
}

#define MFMA32(a, b, c) __builtin_amdgcn_mfma_f32_32x32x16_bf16((a), (b), (c), 0, 0, 0)
DI bf16x8 pack8(const f32x16& x, int s) {
    u32x4 p; p.x = cvt_pk_bf16(x[8 * s], x[8 * s + 1]); p.y = cvt_pk_bf16(x[8 * s + 2], x[8 * s + 3]); p.z = cvt_pk_bf16(x[8 * s + 4], x[8 * s + 5]); p.w = cvt_pk_bf16(x[8 * s + 6], x[8 * s + 7]);
    return __builtin_bit_cast(bf16x8, p);
}

DI void sgu_item(const Params& p, int l, int item, LAS unsigned char* lds, int tid) {
    tid = launder_v(tid); unsigned char* wsl = launder_p(p.ws);
    const bf16_t* P = (const bf16_t*)(wsl + WS_PG); bf16_t* mixed = (bf16_t*)(wsl + WS_Y);
    const int b = item >> 7, rem = item & 127, chunk = rem >> 2, hh = rem & 3;
    const size_t T0 = (size_t)b * SEQ + chunk * 128;
    {
        const int j = tid >> 2, qd = tid & 3;
        const bf16_t* vp = P + (T0 + j) * INW + 512 + 128 * hh + 32 * qd;
        float v[32];
#pragma unroll
        for (int i = 0; i < 4; ++i) { const u32x4 w = *(const u32x4*)(vp + 8 * i);
#pragma unroll
            for (int k = 0; k < 4; ++k) { v[8 * i + 2 * k] = __uint_as_float(w[k] << 16); v[8 * i + 2 * k + 1] = __uint_as_float(w[k] & 0xffff0000u); } }
        float sum = 0.f;
#pragma unroll
        for (int i = 0; i < 32; ++i) sum += v[i];
        sum += __shfl_xor(sum, 1); sum += __shfl_xor(sum, 2);
        const float mu = sum * (1.0f / 128.0f);
        float sq = 0.f;
#pragma unroll
        for (int i = 0; i < 32; ++i) { const float d = v[i] - mu; sq += d * d; }
        sq += __shfl_xor(sq, 1); sq += __shfl_xor(sq, 2);
        const float rstd = rsqrtf(sq * (1.0f / 128.0f) + EPS);
        const float* lg = p.sgu_ln_g + ((size_t)l * 4 + hh) * 128 + 32 * qd; const float* lb = p.sgu_ln_b + ((size_t)l * 4 + hh) * 128 + 32 * qd;
#pragma unroll
        for (int i = 0; i < 32; ++i) { const float o = (v[i] - mu) * rstd * lg[i] + lb[i]; *(LAS bf16_t*)(lds + (32 * qd + i) * 272 + j * 2) = f2bf(o); }
    }
    __syncthreads();
    {
        const int wave = __builtin_amdgcn_readfirstlane(tid >> 6), lane = tid & 63, r = lane & 31, h = lane >> 5;
        const int c0 = 32 * (wave & 3);
        const bf16_t* Wsb = (const bf16_t*)(wsl + WS_SGUW) + ((size_t)l * 4 + hh) * 128 * 128;
#pragma unroll
        for (int q = 0; q < 2; ++q) {
            const int itile = (wave < 4) ? (q ? 3 : 0) : (q ? 2 : 1), i0 = 32 * itile;
            f32x16 acc;
#pragma unroll
            for (int i = 0; i < 16; ++i) acc[i] = 0.f;
            const bf16_t* wrow = Wsb + (size_t)(i0 + r) * 128 + 8 * h;
            const LAS unsigned char* arow = lds + (c0 + r) * 272 + 16 * h;
            for (int ks = 0; ks < 2 * (itile + 1); ++ks) {
                const bf16x8 af = *(const LAS bf16x8*)(arow + ks * 32);
                const bf16x8 bfr = *(const bf16x8*)(wrow + ks * 16);
                acc = MFMA32(af, bfr, acc);
            }
            const float bs = p.sgu_b[((size_t)l * 4 + hh) * 128 + i0 + r];
            const size_t tok = T0 + i0 + r;
#pragma unroll
            for (int g = 0; g < 4; ++g) {
                const int c = c0 + 8 * g + 4 * h;
                const u32x2 uw = *(const u32x2*)(P + tok * INW + 128 * hh + c);
                const float u0 = __uint_as_float(uw.x << 16), u1 = __uint_as_float(uw.x & 0xffff0000u), u2 = __uint_as_float(uw.y << 16), u3 = __uint_as_float(uw.y & 0xffff0000u);
                u32x2 w; w.x = cvt_pk_bf16(u0 * (acc[4 * g] + bs), u1 * (acc[4 * g + 1] + bs)); w.y = cvt_pk_bf16(u2 * (acc[4 * g + 2] + bs), u3 * (acc[4 * g + 3] + bs));
                *(u32x2*)(mixed + tok * DM + 128 * hh + c) = w;
            }
        }
    }
    __syncthreads();
}

constexpr int AT_OPITCH = 136, AT_LSE_OFF = 512 * AT_OPITCH, AT_V_OFF = AT_LSE_OFF + 2048, AT_VPITCH = 144, AT_VBYTES = 32 * AT_VPITCH;
DI void attn_item(const Params& p, int item, LAS unsigned char* lds, int tid) {
    tid = launder_v(tid); unsigned char* wsl = launder_p(p.ws);
    const bf16_t* P = (const bf16_t*)(wsl + WS_PG); bf16_t* mixed = (bf16_t*)(wsl + WS_Y);
    const int wave = __builtin_amdgcn_readfirstlane(tid >> 6), lane = tid & 63, r = lane & 31, h = lane >> 5;
    const int xcd = item & 7, li = item >> 3, bh = (li >> 3) * 8 + xcd, sp = li & 7, b = bh >> 3, hd = bh & 7;
    const bf16_t* Pb = P + (size_t)b * SEQ * INW;
    LAS unsigned char* Ost = lds; LAS float* Lse = (LAS float*)(lds + AT_LSE_OFF); LAS unsigned char* Vst = lds + AT_V_OFF + wave * AT_VBYTES;
    const int vkey = lane >> 1, vhalf = lane & 1;
    const int trq = (lane >> 2) & 3, trp = lane & 3, dhalf = (lane >> 4) & 1;
    const LAS unsigned char* trbase = Vst + (4 * h + trq) * AT_VPITCH + 32 * dhalf + 8 * trp;
    for (int br = 0; br < 3; ++br) {
        const int ldil = 2 * br, dil = 1 << ldil;
        for (int tk = wave; tk < 16; tk += 8) {
            const int res = tk & (dil - 1), qtl = tk >> ldil;
            const int Pq0 = ((sp * 512) >> ldil) + 32 * qtl;
            bf16x8 qf[4];
            { const bf16_t* qp = Pb + (size_t)(res + dil * (Pq0 + r)) * INW + 1024 + 64 * hd + 32 * h;
#pragma unroll
              for (int s = 0; s < 4; ++s) qf[s] = *(const bf16x8*)(qp + 8 * s); }
            f32x16 o0, o1;
#pragma unroll
            for (int i = 0; i < 16; ++i) { o0[i] = 0.f; o1[i] = 0.f; }
            float m = -INFINITY, lsum = 0.f;
            const int kt0 = (Pq0 >= 128) ? -4 : -(Pq0 >> 5);
            bf16x8 kf[4]; u32x4 vr[4];
            { const int P0 = Pq0 + 32 * kt0;
              const bf16_t* kp = Pb + (size_t)(res + dil * (P0 + r)) * INW + 1536 + 64 * hd + 32 * h;
              const bf16_t* vp = Pb + (size_t)(res + dil * (P0 + vkey)) * INW + 2048 + 64 * hd + 32 * vhalf;
#pragma unroll
              for (int s = 0; s < 4; ++s) { kf[s] = *(const bf16x8*)(kp + 8 * s); vr[s] = *(const u32x4*)(vp + 8 * s); } }
            for (int kt = kt0; kt <= 0; ++kt) {
                bf16x8 kn[4]; u32x4 vn[4];
                { const int P0 = Pq0 + 32 * (kt < 0 ? kt + 1 : kt);
                  const bf16_t* kp = Pb + (size_t)(res + dil * (P0 + r)) * INW + 1536 + 64 * hd + 32 * h;
                  const bf16_t* vp = Pb + (size_t)(res + dil * (P0 + vkey)) * INW + 2048 + 64 * hd + 32 * vhalf;
#pragma unroll
                  for (int s = 0; s < 4; ++s) { kn[s] = *(const bf16x8*)(kp + 8 * s); vn[s] = *(const u32x4*)(vp + 8 * s); } }
                f32x16 sc;
#pragma unroll
                for (int i = 0; i < 16; ++i) sc[i] = 0.f;
#pragma unroll
                for (int s = 0; s < 4; ++s) sc = MFMA32(kf[s], qf[s], sc);
                if (kt == -4) {
#pragma unroll
                    for (int i = 0; i < 16; ++i) { const int kk = 8 * (i >> 2) + 4 * h + (i & 3); if (kk < r) sc[i] = -INFINITY; }
                }
                if (kt == 0) {
#pragma unroll
                    for (int i = 0; i < 16; ++i) { const int kk = 8 * (i >> 2) + 4 * h + (i & 3); if (kk > r) sc[i] = -INFINITY; }
                }
                float tmax = sc[0];
#pragma unroll
                for (int i = 1; i < 16; ++i) tmax = fmaxf(tmax, sc[i]);
                tmax = fmaxf(tmax, __shfl_xor(tmax, 32));
                const float mnew = fmaxf(m, tmax), alpha = fast_exp2(m - mnew);
                m = mnew;
                float psum = 0.f;
#pragma unroll
                for (int i = 0; i < 16; ++i) { sc[i] = fast_exp2(sc[i] - mnew); psum += sc[i]; }
                lsum = lsum * alpha + psum;
#pragma unroll
                for (int i = 0; i < 16; ++i) { o0[i] *= alpha; o1[i] *= alpha; }
#pragma unroll
                for (int s = 0; s < 4; ++s) *(LAS u32x4*)(Vst + vkey * AT_VPITCH + 64 * vhalf + 16 * s) = vr[s];
                asm volatile("" ::: "memory");
                const bf16x8 pb0 = pack8(sc, 0), pb1 = pack8(sc, 1);
#pragma unroll
                for (int s2 = 0; s2 < 2; ++s2) {
#pragma unroll
                    for (int dt = 0; dt < 2; ++dt) {
                        const s16x4 lo = __builtin_amdgcn_ds_read_tr16_b64_v4i16((LAS s16x4*)(trbase + (16 * s2) * AT_VPITCH + 64 * dt));
                        const s16x4 hi = __builtin_amdgcn_ds_read_tr16_b64_v4i16((LAS s16x4*)(trbase + (16 * s2 + 8) * AT_VPITCH + 64 * dt));
                        const bf16x8 vf = __builtin_shufflevector(lo, hi, 0, 1, 2, 3, 4, 5, 6, 7);
                        if (dt == 0) o0 = MFMA32(vf, s2 ? pb1 : pb0, o0); else o1 = MFMA32(vf, s2 ? pb1 : pb0, o1);
                    }
                }
                asm volatile("" ::: "memory");
#pragma unroll
                for (int s = 0; s < 4; ++s) { kf[s] = kn[s]; vr[s] = vn[s]; }
            }
            const float ltot = lsum + __shfl_xor(lsum, 32);
            float lse = m + __builtin_amdgcn_logf(ltot);
            float fn = fast_rcp(ltot), fp = 0.f;
            const int tl = res + dil * (32 * qtl + r);
            LAS unsigned char* orow = Ost + tl * AT_OPITCH + 8 * h;
            if (br > 0) {
                const float lp = Lse[tl], mx = fmaxf(lp, lse), wp = fast_exp2(lp - mx), wn = fast_exp2(lse - mx), den = wp + wn, iden = fast_rcp(den);
                fp = wp * iden; fn = fn * wn * iden; lse = mx + __builtin_amdgcn_logf(den);
            }
            if (br < 2) { if (h == 0) Lse[tl] = lse; }
            bf16_t* grow = mixed + ((size_t)b * SEQ + sp * 512 + tl) * DM + 512 + 64 * hd + 4 * h;
#pragma unroll
            for (int dt = 0; dt < 2; ++dt)
#pragma unroll
                for (int g = 0; g < 4; ++g) {
                    float v0 = (dt ? o1 : o0)[4 * g] * fn, v1 = (dt ? o1 : o0)[4 * g + 1] * fn, v2 = (dt ? o1 : o0)[4 * g + 2] * fn, v3 = (dt ? o1 : o0)[4 * g + 3] * fn;
                    if (br > 0) { const u32x2 pw = *(const LAS u32x2*)(orow + 64 * dt + 16 * g);
                        v0 += fp * __uint_as_float(pw.x << 16); v1 += fp * __uint_as_float(pw.x & 0xffff0000u); v2 += fp * __uint_as_float(pw.y << 16); v3 += fp * __uint_as_float(pw.y & 0xffff0000u); }
                    u32x2 w; w.x = cvt_pk_bf16(v0, v1); w.y = cvt_pk_bf16(v2, v3);
                    if (br < 2) *(LAS u32x2*)(orow + 64 * dt + 16 * g) = w; else *(u32x2*)(grow + 32 * dt + 8 * g) = w;
                }
        }
        __syncthreads();
    }
}


#define XB_TMO      128
#define XB_XCNT(j)  (256  + 64 * (j))
#define XB_XSUB(j)  (1280 + 64 * (j))
#define XB_XGEN(j)  (2304 + 64 * (j))
#define XB_TOP      3328
#define XB_TOPGEN   3392
#define XCD_BAR_WORDS 3456
#define XB_SPIN_CAP (1u << 20)
DI unsigned xb_ld(unsigned* p)              { return __hip_atomic_load(p, __ATOMIC_RELAXED, __HIP_MEMORY_SCOPE_AGENT); }
DI unsigned xb_add(unsigned* p, unsigned v) { return __hip_atomic_fetch_add(p, v, __ATOMIC_RELAXED, __HIP_MEMORY_SCOPE_AGENT); }
DI unsigned xb_xcc_id() { return (unsigned)__builtin_amdgcn_s_getreg((3 << 11) | 20) & 0xFu; }
#define XB_SPIN(cond, bar) do { unsigned _sp = 0; while (cond) { __builtin_amdgcn_s_sleep(1); \
    if ((++_sp & 255u) == 0u) { if (xb_ld(&(bar)[XB_TMO])) break; if (_sp > XB_SPIN_CAP) { atomicAdd(&(bar)[XB_TMO], 1u); break; } } } } while (0)
struct XcdBarrier { unsigned* bar; unsigned x; volatile LAS unsigned* st; };
DI XcdBarrier xcd_barrier_post(unsigned* bar, volatile LAS unsigned* st) {
    XcdBarrier b; b.bar = bar; b.x = xb_xcc_id(); b.st = st;
    if (threadIdx.x == 0) (void)xb_add(&bar[XB_XCNT(b.x)], 1u);
    return b;
}
DI void xcd_barrier_complete(unsigned* bar, unsigned x, unsigned& nloc, unsigned& nx) {
    const unsigned G = gridDim.x * gridDim.y * gridDim.z;
    unsigned sum, cnt, mine, sp = 0u;
    for (;;) {
        sum = 0u; cnt = 0u; mine = 0u;
#pragma unroll
        for (unsigned j = 0; j < 16; ++j) { const unsigned c = xb_ld(&bar[XB_XCNT(j)]); sum += c; cnt += (c > 0u) ? 1u : 0u; mine = (j == x) ? c : mine; }
        if (sum == G) break;
        __builtin_amdgcn_s_sleep(1);
        if ((++sp & 255u) == 0u) { if (xb_ld(&bar[XB_TMO])) break; if (sp > XB_SPIN_CAP) { atomicAdd(&bar[XB_TMO], 1u); break; } }
    }
    nloc = mine > 0u ? mine : 1u; nx = cnt > 0u ? cnt : 1u;
}
DI void xcd_barrier(const XcdBarrier& b) {
    asm volatile("s_waitcnt vmcnt(0)" ::: "memory");
    __syncthreads();
    if (threadIdx.x == 0) {
        unsigned* bar = b.bar;
        __builtin_amdgcn_s_waitcnt(0);
        unsigned nloc = b.st[0], nx = b.st[1];
        if (nloc == 0u) { xcd_barrier_complete(bar, b.x, nloc, nx); b.st[0] = nloc; b.st[1] = nx; }
        const unsigned old = xb_add(&bar[XB_XSUB(b.x)], 1u);
        const unsigned gen = old / nloc;
        if (old + 1u == (gen + 1u) * nloc) {
            __builtin_amdgcn_fence(__ATOMIC_RELEASE, "agent");
            asm volatile("s_waitcnt vmcnt(0)" ::: "memory");
            const unsigned og = xb_add(&bar[XB_TOP], 1u);
            const unsigned tg = og / nx;
            if (og + 1u == (tg + 1u) * nx) xb_add(&bar[XB_TOPGEN], 1u);
            else XB_SPIN(xb_ld(&bar[XB_TOPGEN]) == tg, bar);
            __builtin_amdgcn_fence(__ATOMIC_ACQUIRE, "agent");
            xb_add(&bar[XB_XGEN(b.x)], 1u);
            asm volatile("s_waitcnt vmcnt(0)" ::: "memory");
        } else {
            XB_SPIN(xb_ld(&bar[XB_XGEN(b.x)]) == gen, bar);
            __builtin_amdgcn_fence(__ATOMIC_ACQUIRE, "agent");
            asm volatile("s_waitcnt vmcnt(0)" ::: "memory");
        }
    }
    __syncthreads();
}

__global__ void __launch_bounds__(NTHR, 2) fwd_megakernel(Params p) {
    extern __shared__ __attribute__((aligned(16))) unsigned char smem[];
    LAS unsigned char* lds = (LAS unsigned char*)smem;
    cg::grid_group grid = cg::this_grid();
    const int tid = threadIdx.x;
    unsigned char* ws = p.ws;
    volatile LAS unsigned* bst = (volatile LAS unsigned*)(lds + 131072);
    if (tid < 4) bst[tid] = 0u;
    __syncthreads();
    const XcdBarrier xbar = xcd_barrier_post((unsigned*)(ws + WS_BAR), bst);

    prelude_phase(p, lds, tid);
    grid.sync();

    for (int l = 0; l < 2; ++l) {
        for (int sb = 0; sb < 3; ++sb) {
            ws = launder_p(ws);
            const float* modl = (const float*)(ws + WS_MOD) + (size_t)l * 8 * (NADA * DM);
            bf16_t* Y = (bf16_t*)(ws + WS_Y); bf16_t* PG = (bf16_t*)(ws + WS_PG);
            const float* hin = (l == 0 && sb == 0) ? p.x : p.out;
            norm_phase(hin, p.norm_g + ((size_t)l * 3 + sb) * DM, modl + (3 * sb) * DM, modl + (3 * sb + 1) * DM, Y, tid);
            xcd_barrier(xbar);
            const bf16_t* A2; const bf16_t* B2; int K2; float gsc;
            if (sb != 1) {
                const int lf = l * 2 + (sb >> 1);
                pg8::Gemm g{Y, (const bf16_t*)(ws + WS_UP + (size_t)lf * SZ_UP), MTOK, 2 * FF, DM};
                pg8::StaticOrder S; S.init(MTOK, 2 * FF, (int)gridDim.x, (int)blockIdx.x);
                EpiSwiglu E{PG};
                pg8::gemm_phase<EpiSwiglu>(lds, g, S, E);
                xcd_barrier(xbar);
                A2 = PG; B2 = (const bf16_t*)(ws + WS_DN + (size_t)lf * SZ_DN); K2 = FF; gsc = 0.5f;
            } else {
                pg8::Gemm g{Y, (const bf16_t*)(ws + WS_IN + (size_t)l * SZ_IN), MTOK, INW, DM};
                pg8::StaticOrder S; S.init(MTOK, INW, (int)gridDim.x, (int)blockIdx.x);
                EpiIn E{PG, (const float*)(ws + WS_ROPE)};
                pg8::gemm_phase<EpiIn>(lds, g, S, E);
                xcd_barrier(xbar);
                for (int it = blockIdx.x; it < 1024; it += gridDim.x) sgu_item(p, l, it, lds, tid);
                for (int it = blockIdx.x; it < 512; it += gridDim.x) attn_item(p, it, lds, tid);
                xcd_barrier(xbar);
                A2 = Y; B2 = (const bf16_t*)(ws + WS_OUT + (size_t)l * SZ_OUT); K2 = DM; gsc = 1.0f;
            }
            {
                pg8::Gemm g{A2, B2, MTOK, DM, K2};
                pg8::StaticOrder S; S.init(MTOK, DM, (int)gridDim.x, (int)blockIdx.x);
                EpiResid E{hin, p.out, modl + (3 * sb + 2) * DM, gsc};
                pg8::gemm_phase<EpiResid>(lds, g, S, E);
                xcd_barrier(xbar);
            }
        }
    }
    final_norm_phase(p.out, p.final_g, tid);
}

constexpr int LDS_BYTES = 131072 + 16;
extern "C" void kernel_launch(void* const* d_in, const int* in_sizes, int n_in, void* d_out, int out_size, void* d_ws, size_t ws_size, hipStream_t stream) {
    static int grid_blocks = 0;
    if (!grid_blocks) {
        int dev = 0, cus = 0, per_cu = 0;
        hipGetDevice(&dev);
        hipDeviceGetAttribute(&cus, hipDeviceAttributeMultiprocessorCount, dev);
        hipFuncSetAttribute((const void*)fwd_megakernel, hipFuncAttributeMaxDynamicSharedMemorySize, LDS_BYTES);
        hipOccupancyMaxActiveBlocksPerMultiprocessor(&per_cu, (const void*)fwd_megakernel, NTHR, LDS_BYTES);
        if (per_cu < 1) per_cu = 1;
        grid_blocks = cus * per_cu;
        if (ws_size < WS_END) fprintf(stderr, "kernel_launch: workspace too small (%zu < %zu)\n", ws_size, (size_t)WS_END);
    }
    Params p{};
    p.x = (const float*)d_in[0]; p.c = (const float*)d_in[1]; p.ada_w = (const float*)d_in[2]; p.ada_b = (const float*)d_in[3]; p.norm_g = (const float*)d_in[4];
    p.f1g = (const float*)d_in[5]; p.f1u = (const float*)d_in[6]; p.f1d = (const float*)d_in[7]; p.f2g = (const float*)d_in[8]; p.f2u = (const float*)d_in[9]; p.f2d = (const float*)d_in[10];
    p.w_in = (const float*)d_in[11]; p.sgu_ln_g = (const float*)d_in[12]; p.sgu_ln_b = (const float*)d_in[13]; p.sgu_w = (const float*)d_in[14]; p.sgu_b = (const float*)d_in[15];
    p.w_out = (const float*)d_in[16]; p.final_g = (const float*)d_in[17];
    p.out = (float*)d_out; p.ws = (unsigned char*)d_ws;
    (void)hipMemsetAsync((unsigned char*)d_ws + WS_BAR, 0, 16384, stream);
    void* args[] = {&p};
    hipError_t e = hipLaunchCooperativeKernel((const void*)fwd_megakernel, dim3(grid_blocks), dim3(NTHR), args, LDS_BYTES, stream);
    if (e != hipSuccess) fprintf(stderr, "cooperative launch failed: %s (grid %d)\n", hipGetErrorString(e), grid_blocks);
}
```

```cpp
#include <hip/hip_runtime.h>
#include <hip/hip_cooperative_groups.h>
#include <cstdio>
namespace cg = cooperative_groups;

#define LAS __attribute__((address_space(3)))
#define DI __device__ __forceinline__
typedef unsigned short bf16_t;
typedef short bf16x8 __attribute__((ext_vector_type(8)));
typedef short s16x4 __attribute__((ext_vector_type(4)));
typedef float f32x4 __attribute__((ext_vector_type(4)));
typedef float f32x2 __attribute__((ext_vector_type(2)));
typedef float f32x16 __attribute__((ext_vector_type(16)));
typedef unsigned u32x4 __attribute__((ext_vector_type(4)));
typedef unsigned u32x2 __attribute__((ext_vector_type(2)));

constexpr int DM = 1024, NB = 8, SEQ = 4096, MTOK = NB * SEQ, FF = 2816, INW = 2560, NADA = 9;
constexpr int NTHR = 512;
constexpr float EPS = 1e-6f;

constexpr size_t SZ_UP = (size_t)2 * FF * DM * 2;
constexpr size_t SZ_DN = (size_t)DM * FF * 2;
constexpr size_t SZ_IN = (size_t)INW * DM * 2;
constexpr size_t SZ_OUT = (size_t)DM * DM * 2;
constexpr size_t WS_UP = 0;
constexpr size_t WS_DN = WS_UP + 4 * SZ_UP;
constexpr size_t WS_IN = WS_DN + 4 * SZ_DN;
constexpr size_t WS_OUT = WS_IN + 2 * SZ_IN;
constexpr size_t WS_SGUW = WS_OUT + 2 * SZ_OUT;
constexpr size_t WS_MOD = WS_SGUW + (size_t)2 * 4 * 128 * 128 * 2;
constexpr size_t WS_ROPE = WS_MOD + (size_t)2 * 8 * 9216 * 4;
constexpr size_t WS_Y = WS_ROPE + (size_t)4096 * 32 * 8;
constexpr size_t WS_PG = WS_Y + (size_t)MTOK * DM * 2;
constexpr size_t WS_MIX = WS_PG + (size_t)MTOK * FF * 2;
constexpr size_t WS_BUP = WS_MIX + (size_t)MTOK * DM * 2;
constexpr size_t WS_BIN = WS_BUP + (size_t)4 * 8 * 2 * FF * 4;
constexpr size_t WS_BAR = WS_BIN + (size_t)2 * 8 * INW * 4;
constexpr size_t WS_SSQ = WS_BAR + 16384;
constexpr size_t ZERO_BYTES = 16384 + (size_t)7 * MTOK * 4;
constexpr size_t WS_END = WS_BAR + ZERO_BYTES;

struct Params {
    const float *x, *c, *ada_w, *ada_b, *norm_g, *f1g, *f1u, *f1d, *f2g, *f2u, *f2d, *w_in, *sgu_ln_g, *sgu_ln_b, *sgu_w, *sgu_b, *w_out, *final_g;
    float* out; unsigned char* ws;
};

DI int launder_v(int x) { asm volatile("" : "+v"(x)); return x; }
template <class T> DI T* launder_p(T* q) { size_t z = 0; asm volatile("" : "+s"(z)); return (T*)((unsigned char*)q + z); }
DI float bf2f(unsigned short v) { return __uint_as_float((unsigned)v << 16); }
DI unsigned short f2bf(float f) { unsigned u = __float_as_uint(f); u += 0x7fffu + ((u >> 16) & 1u); return (unsigned short)(u >> 16); }
DI unsigned cvt_pk_bf16(float lo, float hi) { unsigned r; asm("v_cvt_pk_bf16_f32 %0, %1, %2" : "=v"(r) : "v"(lo), "v"(hi)); return r; }
DI float fast_exp2(float x) { return __builtin_amdgcn_exp2f(x); }
DI float fast_rcp(float x) { return __builtin_amdgcn_rcpf(x); }
DI float silu_f(float x) { return x * fast_rcp(1.0f + fast_exp2(-1.4426950409f * x)); }
DI float gelu_tanh_f(float x) { const float t = 0.7978845608f * (x + 0.044715f * x * x * x); return x * fast_rcp(1.0f + fast_exp2(-2.8853900818f * t)); }

namespace pg8 {
constexpr int BM = 256, BK = 64, HALF = 128, HTB = HALF * BK * 2, STAGE_BYTES = 8 * HTB, NXCD = 8, WGM = 8;
DI int lds_byte(int r, int c) { const int st = (r >> 4) * 2 + (c >> 5), rr = r & 15, cc = c & 31, ob = rr * 64 + cc * 2; return st * 1024 + (ob ^ (((ob >> 9) & 1) << 5)); }
DI void stage_rc(int b, int& R, int& C) { const int st = b / 1024, sb = b % 1024, swz = sb ^ (((sb >> 9) & 1) << 5); R = (st >> 1) * 16 + swz / 64; C = (st & 1) * 32 + (swz % 64) / 2; }
DI int perm32(int rho) { const int n = rho >> 4, i = rho & 15; return 8 * (i >> 2) + 4 * n + (i & 3); }
struct Unit { int pm, pn; };
struct Gemm { const bf16_t* A; const bf16_t* Bt; int M, N, K; };
struct StaticOrder {
    int nM, nN, nwg, G, c;
    DI void init(int M, int N, int G_, int c_) { nM = M / BM; nN = N / BM; nwg = nM * nN; G = G_; c = c_; }
    DI bool next(int i, Unit& u) const {
        const long L = (long)i * G + c; if (L >= nwg) return false;
        int wgid = (int)L; { const int q = nwg / NXCD, r = nwg % NXCD, xcd = wgid % NXCD, off = wgid / NXCD; wgid = (xcd < r ? xcd * (q + 1) : r * (q + 1) + (xcd - r) * q) + off; }
        const int nig = WGM * nN, gid = wgid / nig, fm = gid * WGM, gsz = (nM - fm) < WGM ? (nM - fm) : WGM;
        u.pm = fm + ((wgid % nig) % gsz); u.pn = (wgid % nig) / gsz; return true;
    }
};

template <class Epi>
DI void gemm_phase(LAS unsigned char* lds, const Gemm g, const StaticOrder& S, const Epi& E) {
    const int tid = launder_v(threadIdx.x), wid = __builtin_amdgcn_readfirstlane(tid >> 6), lane = tid & 63, wr = wid >> 2, wc = wid & 3, fr = lane & 15, fq = lane >> 4;
    const int K = g.K, nt = K / BK;
    unsigned voffA[2], voffB[2];
#pragma unroll
    for (int i = 0; i < 2; ++i) { int R, C; stage_rc(tid * 16 + i * 8192, R, C); const int Rb = Epi::PERM ? ((R & ~31) + perm32(R & 31)) : R;
        voffA[i] = (unsigned)(R * K + C) * 2u; voffB[i] = (unsigned)(Rb * K + C) * 2u; }
    const size_t kstep = (size_t)(BK * 2);
    const size_t hstep = (size_t)HALF * K * 2;
    const size_t tstep = 2 * hstep;
    const unsigned ldsw = (unsigned)wid * 1024u;
    const int aoff = lds_byte(wr * 64 + fr, fq * 8), boff = lds_byte(wc * 32 + fr, fq * 8);
#define PG8_SA(b, h) (((b) * 2 + (h)) * HTB)
#define PG8_SB(b, h) ((4 + (b) * 2 + (h)) * HTB)
#define PG8_STAGE(bufoff, gbase, voff) do { _Pragma("unroll") for (int _i = 0; _i < 2; ++_i) \
        __builtin_amdgcn_global_load_lds((const unsigned*)((const char*)(gbase) + (voff)[_i]), (LAS unsigned*)(lds + (bufoff) + ldsw + _i * 8192), 16, 0, 0); } while (0)
#define PG8_LDA(dst, b, h) do { _Pragma("unroll") for (int m = 0; m < 4; ++m) _Pragma("unroll") for (int k = 0; k < 2; ++k) dst[m][k] = *(const LAS bf16x8*)(lds + PG8_SA(b, h) + aoff + m * 2048 + k * 1024); } while (0)
#define PG8_LDB(dst, b, h) do { _Pragma("unroll") for (int n = 0; n < 2; ++n) _Pragma("unroll") for (int k = 0; k < 2; ++k) dst[n][k] = *(const LAS bf16x8*)(lds + PG8_SB(b, h) + boff + n * 2048 + k * 1024); } while (0)
#define PG8_MMA(ai, bj, At, Bt) do { __builtin_amdgcn_s_setprio(1); _Pragma("unroll") for (int m = 0; m < 4; ++m) _Pragma("unroll") for (int n = 0; n < 2; ++n) _Pragma("unroll") for (int k = 0; k < 2; ++k) \
        acc[ai][bj][m][n] = __builtin_amdgcn_mfma_f32_16x16x32_bf16(Bt[n][k], At[m][k], acc[ai][bj][m][n], 0, 0, 0); __builtin_amdgcn_s_setprio(0); } while (0)
#define PG8_WAIT_V(n) asm volatile("s_waitcnt vmcnt(" #n ")" ::: "memory")
#define PG8_WAIT_L(n) asm volatile("s_waitcnt lgkmcnt(" #n ")" ::: "memory")
#define PG8_BAR __builtin_amdgcn_s_barrier()
#define PG8_SCHED __builtin_amdgcn_sched_barrier(0)
    Unit cur, nxt; int ui = 0;
    if (!S.next(0, cur)) return;
    f32x4 acc[2][2][4][2];
#pragma unroll
    for (int a = 0; a < 2; ++a)
#pragma unroll
        for (int b = 0; b < 2; ++b)
#pragma unroll
            for (int m = 0; m < 4; ++m)
#pragma unroll
                for (int n = 0; n < 2; ++n) acc[a][b][m][n] = (f32x4){0.f, 0.f, 0.f, 0.f};
    bf16x8 At[4][2], B0[2][2], B1[2][2];
    const char* cA = (const char*)g.A + (size_t)cur.pm * tstep; const char* cB = (const char*)g.Bt + (size_t)cur.pn * tstep;
    PG8_STAGE(PG8_SB(0, 0), cB, voffB); PG8_STAGE(PG8_SA(0, 0), cA, voffA); PG8_STAGE(PG8_SB(0, 1), cB + hstep, voffB); PG8_STAGE(PG8_SA(0, 1), cA + hstep, voffA);
    if (wr == 1) PG8_BAR;
    PG8_WAIT_V(4); PG8_BAR;
    PG8_STAGE(PG8_SB(1, 0), cB + kstep, voffB); PG8_STAGE(PG8_SA(1, 0), cA + kstep, voffA); PG8_STAGE(PG8_SB(1, 1), cB + hstep + kstep, voffB);
    PG8_WAIT_V(6); PG8_BAR;
    for (;;) {
        const bool has_next = S.next(ui + 1, nxt);
        const char* nA = has_next ? (const char*)g.A + (size_t)nxt.pm * tstep : cA; const char* nB = has_next ? (const char*)g.Bt + (size_t)nxt.pn * tstep : cB;
        for (int t = 0; t < nt; t += 2) {
            const bool last = (t == nt - 2);
            const char* a1 = cA + (size_t)(t + 1) * kstep;
            const char* a2 = last ? nA : cA + (size_t)(t + 2) * kstep; const char* b2 = last ? nB : cB + (size_t)(t + 2) * kstep;
            const char* a3 = a2 + kstep; const char* b3 = b2 + kstep;
            PG8_LDB(B0, 0, 0); PG8_SCHED; PG8_LDA(At, 0, 0); PG8_STAGE(PG8_SA(1, 1), a1 + hstep, voffA);
            PG8_WAIT_L(8); PG8_BAR; PG8_WAIT_L(0); PG8_MMA(0, 0, At, B0); PG8_BAR; PG8_SCHED;
            PG8_LDB(B1, 0, 1); PG8_STAGE(PG8_SB(0, 0), b2, voffB);
            PG8_BAR; PG8_WAIT_L(0); PG8_MMA(0, 1, At, B1); PG8_BAR;
            PG8_LDA(At, 0, 1); PG8_STAGE(PG8_SA(0, 0), a2, voffA);
            PG8_BAR; PG8_WAIT_L(0); PG8_MMA(1, 0, At, B0); PG8_BAR; PG8_SCHED;
            PG8_STAGE(PG8_SB(0, 1), b2 + hstep, voffB);
            PG8_WAIT_V(6); PG8_BAR; PG8_MMA(1, 1, At, B1); PG8_BAR;
            PG8_LDB(B0, 1, 0); PG8_SCHED; PG8_LDA(At, 1, 0); PG8_STAGE(PG8_SA(0, 1), a2 + hstep, voffA);
            PG8_WAIT_L(8); PG8_BAR; PG8_WAIT_L(0); PG8_MMA(0, 0, At, B0); PG8_BAR; PG8_SCHED;
            PG8_LDB(B1, 1, 1); PG8_STAGE(PG8_SB(1, 0), b3, voffB);
            PG8_BAR; PG8_WAIT_L(0); PG8_MMA(0, 1, At, B1); PG8_BAR;
            PG8_LDA(At, 1, 1); PG8_STAGE(PG8_SA(1, 0), a3, voffA);
            PG8_BAR; PG8_WAIT_L(0); PG8_MMA(1, 0, At, B0); PG8_BAR; PG8_SCHED;
            PG8_STAGE(PG8_SB(1, 1), b3 + hstep, voffB);
            PG8_WAIT_V(6); PG8_BAR; PG8_MMA(1, 1, At, B1); PG8_BAR;
        }
        E(acc, cur, wr, wc, fr, fq);
        if (!has_next) break;
#pragma unroll
        for (int a = 0; a < 2; ++a)
#pragma unroll
            for (int b = 0; b < 2; ++b)
#pragma unroll
                for (int m = 0; m < 4; ++m)
#pragma unroll
                    for (int n = 0; n < 2; ++n) acc[a][b][m][n] = (f32x4){0.f, 0.f, 0.f, 0.f};
        cur = nxt; cA = nA; cB = nB; ++ui;
    }
    PG8_WAIT_V(0);
    if (wr == 0) PG8_BAR;
    PG8_BAR;
#undef PG8_SA
#undef PG8_SB
#undef PG8_STAGE
#undef PG8_LDA
#undef PG8_LDB
#undef PG8_MMA
#undef PG8_WAIT_V
#undef PG8_WAIT_L
#undef PG8_BAR
#undef PG8_SCHED
}
}

struct EpiSwiglu {
    static constexpr bool PERM = true;
    bf16_t* G; const float* ssq; const float* bias;
    DI void operator()(const f32x4 (&acc)[2][2][4][2], const pg8::Unit& u, int wr, int wc, int fr, int fq) const {
        const int row0 = u.pm * 256 + wr * 64 + fr, col0 = u.pn * 128 + wc * 32 + 8 * fq, b = (u.pm * 256) / SEQ;
        const float* bp = bias + (size_t)b * (2 * FF) + u.pn * 256 + wc * 32 + 8 * fq;
        const f32x4 bg0 = *(const f32x4*)bp, bg1 = *(const f32x4*)(bp + 4), bu0 = *(const f32x4*)(bp + 128), bu1 = *(const f32x4*)(bp + 132);
        float sq[8];
#pragma unroll
        for (int i = 0; i < 8; ++i) sq[i] = ssq[row0 + (i >> 2) * 128 + (i & 3) * 16];
#pragma unroll
        for (int ai = 0; ai < 2; ++ai)
#pragma unroll
            for (int m = 0; m < 4; ++m) {
                bf16_t* rowp = G + (size_t)(row0 + ai * 128 + m * 16) * FF + col0;
                const float rstd = rsqrtf(sq[ai * 4 + m] * (1.0f / DM) + EPS);
                const f32x4 g0 = acc[ai][0][m][0] * rstd + bg0, g1 = acc[ai][0][m][1] * rstd + bg1, u0 = acc[ai][1][m][0] * rstd + bu0, u1 = acc[ai][1][m][1] * rstd + bu1;
                u32x4 w;
                w.x = cvt_pk_bf16(silu_f(g0[0]) * u0[0], silu_f(g0[1]) * u0[1]); w.y = cvt_pk_bf16(silu_f(g0[2]) * u0[2], silu_f(g0[3]) * u0[3]);
                w.z = cvt_pk_bf16(silu_f(g1[0]) * u1[0], silu_f(g1[1]) * u1[1]); w.w = cvt_pk_bf16(silu_f(g1[2]) * u1[2], silu_f(g1[3]) * u1[3]);
                *(u32x4*)rowp = w;
            }
    }
};
struct EpiResid {
    static constexpr bool PERM = false;
    const float* hin; float* hout; const float* gate;
    bf16_t* ynext; float* ssqn; const float* gnext; const float* scnext;
    float gscale, pad_;
    DI void operator()(const f32x4 (&acc)[2][2][4][2], const pg8::Unit& u, int wr, int wc, int fr, int fq) const {
        const int row0 = u.pm * 256 + wr * 64 + fr, col0 = u.pn * 256 + wc * 32 + 4 * fq, b = (u.pm * 256) / SEQ;
        const bool has_y = ynext != nullptr;
        f32x4 gv[2][2], gm[2][2];
#pragma unroll
        for (int bj = 0; bj < 2; ++bj)
#pragma unroll
            for (int n = 0; n < 2; ++n) {
                gv[bj][n] = *(const f32x4*)(gate + (size_t)b * (NADA * DM) + col0 + bj * 128 + n * 16) * gscale;
                gm[bj][n] = *(const f32x4*)(gnext + col0 + bj * 128 + n * 16) * (*(const f32x4*)(scnext + (size_t)b * (NADA * DM) + col0 + bj * 128 + n * 16) + 1.0f);
            }
        f32x4 hv[2][2];
        { const size_t off = (size_t)row0 * DM + col0;
#pragma unroll
          for (int bj = 0; bj < 2; ++bj)
#pragma unroll
              for (int n = 0; n < 2; ++n) hv[bj][n] = *(const f32x4*)(hin + off + bj * 128 + n * 16); }
#pragma unroll
        for (int it = 0; it < 8; ++it) {
            const int ai = it >> 2, m = it & 3;
            const size_t off = (size_t)(row0 + ai * 128 + m * 16) * DM + col0;
            f32x4 hn2[2][2];
            if (it < 7) { const size_t off2 = (size_t)(row0 + ((it + 1) >> 2) * 128 + ((it + 1) & 3) * 16) * DM + col0;
#pragma unroll
                for (int bj = 0; bj < 2; ++bj)
#pragma unroll
                    for (int n = 0; n < 2; ++n) hn2[bj][n] = *(const f32x4*)(hin + off2 + bj * 128 + n * 16); }
            __builtin_amdgcn_sched_barrier(0);
            float rs = 0.f;
#pragma unroll
            for (int bj = 0; bj < 2; ++bj)
#pragma unroll
                for (int n = 0; n < 2; ++n) {
                    const f32x4 hn = hv[bj][n] + gv[bj][n] * acc[ai][bj][m][n];
                    *(f32x4*)(hout + off + bj * 128 + n * 16) = hn;
                    rs += hn[0] * hn[0] + hn[1] * hn[1] + hn[2] * hn[2] + hn[3] * hn[3];
                    if (has_y) { const f32x4 a = hn * gm[bj][n]; u32x2 w; w.x = cvt_pk_bf16(a[0], a[1]); w.y = cvt_pk_bf16(a[2], a[3]); *(u32x2*)(ynext + off + bj * 128 + n * 16) = w; }
                }
            rs += __shfl_xor(rs, 16); rs += __shfl_xor(rs, 32);
            if (fq == 0) (void)__hip_atomic_fetch_add(ssqn + row0 + ai * 128 + m * 16, rs, __ATOMIC_RELAXED, __HIP_MEMORY_SCOPE_AGENT);
            if (it < 7) {
#pragma unroll
                for (int bj = 0; bj < 2; ++bj)
#pragma unroll
                    for (int n = 0; n < 2; ++n) hv[bj][n] = hn2[bj][n]; }
        }
    }
};
struct EpiIn {
    static constexpr bool PERM = true;
    bf16_t* P; const float* rope; const float* ssq; const float* bias;
    DI void operator()(const f32x4 (&acc)[2][2][4][2], const pg8::Unit& u, int wr, int wc, int fr, int fq) const {
        const int row0 = u.pm * 256 + wr * 64 + fr, col0 = u.pn * 256 + wc * 32 + 8 * fq, kind = u.pn >> 1, b = (u.pm * 256) / SEQ;
        const int i0 = 16 * (wc & 1) + 4 * fq;
        const bool is_rope = (kind == 2 || kind == 3);
        const float* bp = bias + (size_t)b * INW + col0;
        const f32x4 bv00 = *(const f32x4*)bp, bv01 = *(const f32x4*)(bp + 4), bv10 = *(const f32x4*)(bp + 128), bv11 = *(const f32x4*)(bp + 132);
        float sq[8];
#pragma unroll
        for (int i = 0; i < 8; ++i) sq[i] = ssq[row0 + (i >> 2) * 128 + (i & 3) * 16];
        const float qs = (kind == 2) ? 0.125f * 1.4426950409f : 1.0f;
        f32x4 cs0 = {1.f, 0.f, 1.f, 0.f}, cs1 = {1.f, 0.f, 1.f, 0.f};
        if (is_rope) { const f32x4* rp = (const f32x4*)(rope + ((size_t)(row0 & (SEQ - 1)) * 32 + i0) * 2); cs0 = rp[0]; cs1 = rp[1]; }
#pragma unroll
        for (int it = 0; it < 8; ++it) {
            const int ai = it >> 2, m = it & 3;
            const int row = row0 + ai * 128 + m * 16;
            bf16_t* rowp = P + (size_t)row * INW + col0;
            const float rstd = rsqrtf(sq[it] * (1.0f / DM) + EPS);
            f32x4 cn0 = cs0, cn1 = cs1;
            if (is_rope && it < 7) { const int row2 = row0 + ((it + 1) >> 2) * 128 + ((it + 1) & 3) * 16;
                const f32x4* rp = (const f32x4*)(rope + ((size_t)(row2 & (SEQ - 1)) * 32 + i0) * 2); cn0 = rp[0]; cn1 = rp[1]; }
            __builtin_amdgcn_sched_barrier(0);
#pragma unroll
            for (int bj = 0; bj < 2; ++bj) {
                f32x4 v0 = acc[ai][bj][m][0] * rstd + (bj ? bv10 : bv00), v1 = acc[ai][bj][m][1] * rstd + (bj ? bv11 : bv01);
                if (kind <= 1) {
#pragma unroll
                    for (int j = 0; j < 4; ++j) { v0[j] = gelu_tanh_f(v0[j]); v1[j] = gelu_tanh_f(v1[j]); }
                } else if (kind <= 3) {
#pragma unroll
                    for (int j = 0; j < 4; ++j) { const float cj = (j < 2 ? cs0 : cs1)[(j & 1) * 2], sj = (j < 2 ? cs0 : cs1)[(j & 1) * 2 + 1];
                        const float x1 = v0[j], x2 = v1[j]; v0[j] = (x1 * cj - x2 * sj) * qs; v1[j] = (x2 * cj + x1 * sj) * qs; }
                }
                u32x4 w; w.x = cvt_pk_bf16(v0[0], v0[1]); w.y = cvt_pk_bf16(v0[2], v0[3]); w.z = cvt_pk_bf16(v1[0], v1[1]); w.w = cvt_pk_bf16(v1[2], v1[3]);
                *(u32x4*)(rowp + bj * 128) = w;
            }
            cs0 = cn0; cs1 = cn1;
        }
    }
};

DI void tr_tile(const float* src, int ld_src, int srccol0, int k0, bf16_t* dst, int ld_dst, int n0, bool rperm, LAS float* tile, int tid) {
#pragma unroll
    for (int i = 0; i < 2; ++i) {
        const int idx = tid + i * NTHR, row = idx >> 4, c4 = idx & 15;
        const f32x4 v = *(const f32x4*)(src + (size_t)(k0 + row) * ld_src + srccol0 + c4 * 4);
        LAS float* t = tile + row * 65 + c4 * 4; t[0] = v[0]; t[1] = v[1]; t[2] = v[2]; t[3] = v[3];
    }
    __syncthreads();
    const int p = tid >> 3, kc = (tid & 7) * 8;
    const int pp = rperm ? (4 * (p >> 3) + (p & 3) + 32 * ((p >> 2) & 1)) : p;
    float v[8];
#pragma unroll
    for (int j = 0; j < 8; ++j) v[j] = tile[(kc + j) * 65 + pp];
    u32x4 w; w.x = cvt_pk_bf16(v[0], v[1]); w.y = cvt_pk_bf16(v[2], v[3]); w.z = cvt_pk_bf16(v[4], v[5]); w.w = cvt_pk_bf16(v[6], v[7]);
    *(u32x4*)(dst + (size_t)(n0 + p) * ld_dst + k0 + kc) = w;
    __syncthreads();
}

constexpr int IT_MOD = 288;
constexpr int IT_ROPE = 256, IT_SGUW = 256;
constexpr int T_UP = 88 * 16, T_DN = 16 * 44, T_IN = 40 * 16, T_OUT = 16 * 16;
constexpr int IT_UP0 = IT_MOD + IT_ROPE + IT_SGUW, IT_DN0 = IT_UP0 + 4 * T_UP, IT_IN0 = IT_DN0 + 4 * T_DN, IT_OUT0 = IT_IN0 + 2 * T_IN, IT_END = IT_OUT0 + 2 * T_OUT;

DI void prelude_phase(const Params& p, LAS unsigned char* lds, int tid) {
    unsigned char* ws = p.ws;
    for (int it = blockIdx.x; it < IT_END; it += gridDim.x) {
        if (it < IT_MOD) {
            const int l = it / 144, cb = it % 144;
            LAS float* s = (LAS float*)lds; LAS float* red = (LAS float*)(lds + 32768);
            for (int i = tid; i < NB * DM; i += NTHR) s[i] = silu_f(p.c[i]);
            __syncthreads();
            const int cp = tid & 31, kg = tid >> 5;
            float a[8][2];
#pragma unroll
            for (int b = 0; b < 8; ++b) { a[b][0] = 0.f; a[b][1] = 0.f; }
            const float* w = p.ada_w + (size_t)l * DM * (NADA * DM) + (size_t)(kg * 64) * (NADA * DM) + cb * 64 + cp * 2;
#pragma unroll 4
            for (int k = 0; k < 64; ++k) {
                const f32x2 wv = *(const f32x2*)(w + (size_t)k * (NADA * DM));
#pragma unroll
                for (int b = 0; b < 8; ++b) { const float sv = s[b * DM + kg * 64 + k]; a[b][0] += sv * wv.x; a[b][1] += sv * wv.y; }
            }
#pragma unroll
            for (int b = 0; b < 8; ++b) { red[(kg * 8 + b) * 64 + cp * 2] = a[b][0]; red[(kg * 8 + b) * 64 + cp * 2 + 1] = a[b][1]; }
            __syncthreads();
            { const int b = tid >> 6, col = tid & 63; float sum = 0.f;
#pragma unroll
              for (int g = 0; g < 16; ++g) sum += red[(g * 8 + b) * 64 + col];
              const int n = cb * 64 + col;
              ((float*)(ws + WS_MOD))[((size_t)l * 8 + b) * (NADA * DM) + n] = sum + p.ada_b[(size_t)l * (NADA * DM) + n]; }
            __syncthreads();
        } else if (it < IT_MOD + IT_ROPE) {
            const int idx = (it - IT_MOD) * NTHR + tid, pos = idx >> 5, i = idx & 31;
            const float inv = exp2f(-(float)i * (13.287712379549449f / 32.0f));
            const float ang = (float)pos * inv;
            const double rev = (double)ang * 0.15915494309189535;
            const float fr = (float)(rev - floor(rev));
            f32x2 cs; cs.x = __builtin_amdgcn_cosf(fr); cs.y = __builtin_amdgcn_sinf(fr);
            ((f32x2*)(ws + WS_ROPE))[idx] = cs;
        } else if (it < IT_UP0) {
            const int idx = (it - IT_MOD - IT_ROPE) * NTHR + tid, j = idx & 127, i = (idx >> 7) & 127;
            ((bf16_t*)(ws + WS_SGUW))[idx] = (j <= i) ? f2bf(p.sgu_w[idx]) : (bf16_t)0;
        } else if (it < IT_DN0) {
            const int r = it - IT_UP0, lf = r / T_UP, t = r % T_UP, nb = t >> 4, kb = t & 15, l = lf >> 1, f = lf & 1;
            const int n0 = nb * 64, tl = n0 >> 8, half = (n0 >> 7) & 1, j0 = n0 & 127;
            const float* src = (f ? (half ? p.f2u : p.f2g) : (half ? p.f1u : p.f1g)) + (size_t)l * DM * FF;
            tr_tile(src, FF, tl * 128 + j0, kb * 64, (bf16_t*)(ws + WS_UP + (size_t)lf * SZ_UP), DM, n0, false, (LAS float*)lds, tid);
        } else if (it < IT_IN0) {
            const int r = it - IT_DN0, lf = r / T_DN, t = r % T_DN, nb = t / 44, kb = t % 44, l = lf >> 1, f = lf & 1;
            const float* src = (f ? p.f2d : p.f1d) + (size_t)l * FF * DM;
            tr_tile(src, DM, nb * 64, kb * 64, (bf16_t*)(ws + WS_DN + (size_t)lf * SZ_DN), FF, nb * 64, false, (LAS float*)lds, tid);
        } else if (it < IT_OUT0) {
            const int r = it - IT_IN0, l = r / T_IN, t = r % T_IN, nb = t >> 4, kb = t & 15, n0 = nb * 64;
            tr_tile(p.w_in + (size_t)l * DM * INW, INW, n0, kb * 64, (bf16_t*)(ws + WS_IN + (size_t)l * SZ_IN), DM, n0, (n0 >= 1024 && n0 < 2048), (LAS float*)lds, tid);
        } else {
            const int r = it - IT_OUT0, l = r / T_OUT, t = r % T_OUT, nb = t >> 4, kb = t & 15;
            tr_tile(p.w_out + (size_t)l * DM * DM, DM, nb * 64, kb * 64, (bf16_t*)(ws + WS_OUT + (size_t)l * SZ_OUT), DM, nb * 64, false, (LAS float*)lds, tid);
        }
    }
}

DI float wave_sum(float v) {
#pragma unroll
    for (int o = 32; o >= 1; o >>= 1) v += __shfl_xor(v, o);
    return v;
}
DI void norm0_phase(const float* h, const float* g, const float* sc, bf16_t* y, float* ssq, int tid) {
    tid = launder_v(tid);
    const int wave = tid >> 6, lane = tid & 63;
    for (int row = blockIdx.x * 8 + wave; row < MTOK; row += gridDim.x * 8) {
        const int b = row / SEQ;
        const float* hp = h + (size_t)row * DM;
        f32x4 v[4]; float ss = 0.f;
#pragma unroll
        for (int i = 0; i < 4; ++i) { v[i] = *(const f32x4*)(hp + i * 256 + lane * 4); ss += v[i][0] * v[i][0] + v[i][1] * v[i][1] + v[i][2] * v[i][2] + v[i][3] * v[i][3]; }
        ss = wave_sum(ss);
        if (lane == 0) ssq[row] = ss;
#pragma unroll
        for (int i = 0; i < 4; ++i) {
            const int col = i * 256 + lane * 4;
            const f32x4 gv = *(const f32x4*)(g + col), sv = *(const f32x4*)(sc + (size_t)b * (NADA * DM) + col);
            const f32x4 o = v[i] * gv * (sv + 1.0f);
            u32x2 w; w.x = cvt_pk_bf16(o[0], o[1]); w.y = cvt_pk_bf16(o[2], o[3]);
            *(u32x2*)(y + (size_t)row * DM + col) = w;
        }
    }
}
DI void bias_phase(unsigned char* ws, int tid) {
    tid = launder_v(tid);
    const int wave = tid >> 6, lane = tid & 63;
    const float* mod = (const float*)(ws + WS_MOD);
    for (int ri = blockIdx.x * 8 + wave; ri < 4 * 2 * FF + 2 * INW; ri += gridDim.x * 8) {
        const bf16_t* bt; const float* sh; float* outp; int bstride;
        if (ri < 4 * 2 * FF) { const int lf = ri / (2 * FF), n = ri % (2 * FF), l = lf >> 1, sb = (lf & 1) * 2;
            bt = (const bf16_t*)(ws + WS_UP + (size_t)lf * SZ_UP) + (size_t)n * DM; sh = mod + (size_t)l * 8 * (NADA * DM) + (3 * sb) * DM;
            outp = (float*)(ws + WS_BUP) + (size_t)lf * 8 * (2 * FF) + n; bstride = 2 * FF;
        } else { const int r2 = ri - 4 * 2 * FF, l = r2 / INW, n = r2 % INW;
            bt = (const bf16_t*)(ws + WS_IN + (size_t)l * SZ_IN) + (size_t)n * DM; sh = mod + (size_t)l * 8 * (NADA * DM) + 3 * DM;
            outp = (float*)(ws + WS_BIN) + (size_t)l * 8 * INW + n; bstride = INW; }
        float w[16];
#pragma unroll
        for (int i = 0; i < 2; ++i) { const u32x4 q = *(const u32x4*)(bt + lane * 16 + 8 * i);
#pragma unroll
            for (int k = 0; k < 4; ++k) { w[8 * i + 2 * k] = __uint_as_float(q[k] << 16); w[8 * i + 2 * k + 1] = __uint_as_float(q[k] & 0xffff0000u); } }
        float res = 0.f;
#pragma unroll
        for (int b = 0; b < 8; ++b) {
            float d = 0.f;
#pragma unroll
            for (int i = 0; i < 4; ++i) { const f32x4 sv = *(const f32x4*)(sh + (size_t)b * (NADA * DM) + lane * 16 + 4 * i); d += sv[0] * w[4 * i] + sv[1] * w[4 * i + 1] + sv[2] * w[4 * i + 2] + sv[3] * w[4 * i + 3]; }
            d = wave_sum(d);
            res = (lane == b) ? d : res;
        }
        if (lane < 8) outp[(size_t)lane * bstride] = res;
    }
}
DI void final_norm_phase(float* h, const float* g, const float* ssq, int tid) {
    const int wave = tid >> 6, lane = tid & 63;
    for (int row = blockIdx.x * 8 + wave; row < MTOK; row += gridDim.x * 8) {
        float* hp = h + (size_t)row * DM;
        const float rstd = rsqrtf(ssq[row] * (1.0f / DM) + EPS);
#pragma unroll
        for (int i = 0; i < 4; ++i) { const int col = i * 256 + lane * 4; const f32x4 gv = *(const f32x4*)(g + col); *(f32x4*)(hp + col) = *(const f32x4*)(hp + col) * rstd * gv; }
    }
}

#define MFMA32(a, b, c) __builtin_amdgcn_mfma_f32_32x32x16_bf16((a), (b), (c), 0, 0, 0)
DI bf16x8 pack8(const f32x16& x, int s) {
    u32x4 p; p.x = cvt_pk_bf16(x[8 * s], x[8 * s + 1]); p.y = cvt_pk_bf16(x[8 * s + 2], x[8 * s + 3]); p.z = cvt_pk_bf16(x[8 * s + 4], x[8 * s + 5]); p.w = cvt_pk_bf16(x[8 * s + 6], x[8 * s + 7]);
    return __builtin_bit_cast(bf16x8, p);
}

DI void sgu_item(const Params& p, int l, int item, LAS unsigned char* lds, int tid) {
    tid = launder_v(tid); unsigned char* wsl = launder_p(p.ws);
    const bf16_t* P = (const bf16_t*)(wsl + WS_PG); bf16_t* mixed = (bf16_t*)(wsl + WS_MIX);
    const int b = item >> 7, rem = item & 127, chunk = rem >> 2, hh = rem & 3;
    const size_t T0 = (size_t)b * SEQ + chunk * 128;
    {
        const int j = tid >> 2, qd = tid & 3;
        const bf16_t* vp = P + (T0 + j) * INW + 512 + 128 * hh + 32 * qd;
        float v[32];
#pragma unroll
        for (int i = 0; i < 4; ++i) { const u32x4 w = *(const u32x4*)(vp + 8 * i);
#pragma unroll
            for (int k = 0; k < 4; ++k) { v[8 * i + 2 * k] = __uint_as_float(w[k] << 16); v[8 * i + 2 * k + 1] = __uint_as_float(w[k] & 0xffff0000u); } }
        float sum = 0.f;
#pragma unroll
        for (int i = 0; i < 32; ++i) sum += v[i];
        sum += __shfl_xor(sum, 1); sum += __shfl_xor(sum, 2);
        const float mu = sum * (1.0f / 128.0f);
        float sq = 0.f;
#pragma unroll
        for (int i = 0; i < 32; ++i) { const float d = v[i] - mu; sq += d * d; }
        sq += __shfl_xor(sq, 1); sq += __shfl_xor(sq, 2);
        const float rstd = rsqrtf(sq * (1.0f / 128.0f) + EPS);
        const float* lg = p.sgu_ln_g + ((size_t)l * 4 + hh) * 128 + 32 * qd; const float* lb = p.sgu_ln_b + ((size_t)l * 4 + hh) * 128 + 32 * qd;
#pragma unroll
        for (int i = 0; i < 32; ++i) { const float o = (v[i] - mu) * rstd * lg[i] + lb[i]; *(LAS bf16_t*)(lds + (32 * qd + i) * 272 + j * 2) = f2bf(o); }
    }
    __syncthreads();
    {
        const int wave = __builtin_amdgcn_readfirstlane(tid >> 6), lane = tid & 63, r = lane & 31, h = lane >> 5;
        const int c0 = 32 * (wave & 3);
        const bf16_t* Wsb = (const bf16_t*)(wsl + WS_SGUW) + ((size_t)l * 4 + hh) * 128 * 128;
#pragma unroll
        for (int q = 0; q < 2; ++q) {
            const int itile = (wave < 4) ? (q ? 3 : 0) : (q ? 2 : 1), i0 = 32 * itile;
            f32x16 acc;
#pragma unroll
            for (int i = 0; i < 16; ++i) acc[i] = 0.f;
            const bf16_t* wrow = Wsb + (size_t)(i0 + r) * 128 + 8 * h;
            const LAS unsigned char* arow = lds + (c0 + r) * 272 + 16 * h;
            for (int ks = 0; ks < 2 * (itile + 1); ++ks) {
                const bf16x8 af = *(const LAS bf16x8*)(arow + ks * 32);
                const bf16x8 bfr = *(const bf16x8*)(wrow + ks * 16);
                acc = MFMA32(af, bfr, acc);
            }
            const float bs = p.sgu_b[((size_t)l * 4 + hh) * 128 + i0 + r];
            const size_t tok = T0 + i0 + r;
#pragma unroll
            for (int g = 0; g < 4; ++g) {
                const int c = c0 + 8 * g + 4 * h;
                const u32x2 uw = *(const u32x2*)(P + tok * INW + 128 * hh + c);
                const float u0 = __uint_as_float(uw.x << 16), u1 = __uint_as_float(uw.x & 0xffff0000u), u2 = __uint_as_float(uw.y << 16), u3 = __uint_as_float(uw.y & 0xffff0000u);
                u32x2 w; w.x = cvt_pk_bf16(u0 * (acc[4 * g] + bs), u1 * (acc[4 * g + 1] + bs)); w.y = cvt_pk_bf16(u2 * (acc[4 * g + 2] + bs), u3 * (acc[4 * g + 3] + bs));
                *(u32x2*)(mixed + tok * DM + 128 * hh + c) = w;
            }
        }
    }
    __syncthreads();
}

constexpr int AT_OPITCH = 136, AT_LSE_OFF = 512 * AT_OPITCH, AT_V_OFF = AT_LSE_OFF + 2048, AT_VPITCH = 144, AT_VBYTES = 32 * AT_VPITCH;
DI void attn_item(const Params& p, int item, LAS unsigned char* lds, int tid) {
    tid = launder_v(tid); unsigned char* wsl = launder_p(p.ws);
    const bf16_t* P = (const bf16_t*)(wsl + WS_PG); bf16_t* mixed = (bf16_t*)(wsl + WS_MIX);
    const int wave = __builtin_amdgcn_readfirstlane(tid >> 6), lane = tid & 63, r = lane & 31, h = lane >> 5;
    const int xcd = item & 7, li = item >> 3, bh = (li >> 3) * 8 + xcd, sp = li & 7, b = bh >> 3, hd = bh & 7;
    const bf16_t* Pb = P + (size_t)b * SEQ * INW;
    LAS unsigned char* Ost = lds; LAS float* Lse = (LAS float*)(lds + AT_LSE_OFF); LAS unsigned char* Vst = lds + AT_V_OFF + wave * AT_VBYTES;
    const int vkey = lane >> 1, vhalf = lane & 1;
    const int trq = (lane >> 2) & 3, trp = lane & 3, dhalf = (lane >> 4) & 1;
    const LAS unsigned char* trbase = Vst + (4 * h + trq) * AT_VPITCH + 32 * dhalf + 8 * trp;
    for (int br = 0; br < 3; ++br) {
        const int ldil = 2 * br, dil = 1 << ldil;
        for (int tk = wave; tk < 16; tk += 8) {
            const int res = tk & (dil - 1), qtl = tk >> ldil;
            const int Pq0 = ((sp * 512) >> ldil) + 32 * qtl;
            bf16x8 qf[4];
            { const bf16_t* qp = Pb + (size_t)(res + dil * (Pq0 + r)) * INW + 1024 + 64 * hd + 32 * h;
#pragma unroll
              for (int s = 0; s < 4; ++s) qf[s] = *(const bf16x8*)(qp + 8 * s); }
            f32x16 o0, o1;
#pragma unroll
            for (int i = 0; i < 16; ++i) { o0[i] = 0.f; o1[i] = 0.f; }
            float m = -INFINITY, lsum = 0.f;
            const int kt0 = (Pq0 >= 128) ? -4 : -(Pq0 >> 5);
            bf16x8 kf[4]; u32x4 vr[4];
            { const int P0 = Pq0 + 32 * kt0;
              const bf16_t* kp = Pb + (size_t)(res + dil * (P0 + r)) * INW + 1536 + 64 * hd + 32 * h;
              const bf16_t* vp = Pb + (size_t)(res + dil * (P0 + vkey)) * INW + 2048 + 64 * hd + 32 * vhalf;
#pragma unroll
              for (int s = 0; s < 4; ++s) { kf[s] = *(const bf16x8*)(kp + 8 * s); vr[s] = *(const u32x4*)(vp + 8 * s); } }
            for (int kt = kt0; kt <= 0; ++kt) {
                bf16x8 kn[4]; u32x4 vn[4];
                { const int P0 = Pq0 + 32 * (kt < 0 ? kt + 1 : kt);
                  const bf16_t* kp = Pb + (size_t)(res + dil * (P0 + r)) * INW + 1536 + 64 * hd + 32 * h;
                  const bf16_t* vp = Pb + (size_t)(res + dil * (P0 + vkey)) * INW + 2048 + 64 * hd + 32 * vhalf;
#pragma unroll
                  for (int s = 0; s < 4; ++s) { kn[s] = *(const bf16x8*)(kp + 8 * s); vn[s] = *(const u32x4*)(vp + 8 * s); } }
                f32x16 sc;
#pragma unroll
                for (int i = 0; i < 16; ++i) sc[i] = 0.f;
#pragma unroll
                for (int s = 0; s < 4; ++s) sc = MFMA32(kf[s], qf[s], sc);
                if (kt == -4) {
#pragma unroll
                    for (int i = 0; i < 16; ++i) { const int kk = 8 * (i >> 2) + 4 * h + (i & 3); if (kk < r) sc[i] = -INFINITY; }
                }
                if (kt == 0) {
#pragma unroll
                    for (int i = 0; i < 16; ++i) { const int kk = 8 * (i >> 2) + 4 * h + (i & 3); if (kk > r) sc[i] = -INFINITY; }
                }
                float tmax = sc[0];
#pragma unroll
                for (int i = 1; i < 16; ++i) tmax = fmaxf(tmax, sc[i]);
                tmax = fmaxf(tmax, __shfl_xor(tmax, 32));
                const float mnew = fmaxf(m, tmax), alpha = fast_exp2(m - mnew);
                m = mnew;
                float psum = 0.f;
#pragma unroll
                for (int i = 0; i < 16; ++i) { sc[i] = fast_exp2(sc[i] - mnew); psum += sc[i]; }
                lsum = lsum * alpha + psum;
#pragma unroll
                for (int i = 0; i < 16; ++i) { o0[i] *= alpha; o1[i] *= alpha; }
#pragma unroll
                for (int s = 0; s < 4; ++s) *(LAS u32x4*)(Vst + vkey * AT_VPITCH + 64 * vhalf + 16 * s) = vr[s];
                asm volatile("" ::: "memory");
                const bf16x8 pb0 = pack8(sc, 0), pb1 = pack8(sc, 1);
#pragma unroll
                for (int s2 = 0; s2 < 2; ++s2) {
#pragma unroll
                    for (int dt = 0; dt < 2; ++dt) {
                        const s16x4 lo = __builtin_amdgcn_ds_read_tr16_b64_v4i16((LAS s16x4*)(trbase + (16 * s2) * AT_VPITCH + 64 * dt));
                        const s16x4 hi = __builtin_amdgcn_ds_read_tr16_b64_v4i16((LAS s16x4*)(trbase + (16 * s2 + 8) * AT_VPITCH + 64 * dt));
                        const bf16x8 vf = __builtin_shufflevector(lo, hi, 0, 1, 2, 3, 4, 5, 6, 7);
                        if (dt == 0) o0 = MFMA32(vf, s2 ? pb1 : pb0, o0); else o1 = MFMA32(vf, s2 ? pb1 : pb0, o1);
                    }
                }
                asm volatile("" ::: "memory");
#pragma unroll
                for (int s = 0; s < 4; ++s) { kf[s] = kn[s]; vr[s] = vn[s]; }
            }
            const float ltot = lsum + __shfl_xor(lsum, 32);
            float lse = m + __builtin_amdgcn_logf(ltot);
            float fn = fast_rcp(ltot), fp = 0.f;
            const int tl = res + dil * (32 * qtl + r);
            LAS unsigned char* orow = Ost + tl * AT_OPITCH + 8 * h;
            if (br > 0) {
                const float lp = Lse[tl], mx = fmaxf(lp, lse), wp = fast_exp2(lp - mx), wn = fast_exp2(lse - mx), den = wp + wn, iden = fast_rcp(den);
                fp = wp * iden; fn = fn * wn * iden; lse = mx + __builtin_amdgcn_logf(den);
            }
            if (br < 2) { if (h == 0) Lse[tl] = lse; }
            bf16_t* grow = mixed + ((size_t)b * SEQ + sp * 512 + tl) * DM + 512 + 64 * hd + 4 * h;
#pragma unroll
            for (int dt = 0; dt < 2; ++dt)
#pragma unroll
                for (int g = 0; g < 4; ++g) {
                    float v0 = (dt ? o1 : o0)[4 * g] * fn, v1 = (dt ? o1 : o0)[4 * g + 1] * fn, v2 = (dt ? o1 : o0)[4 * g + 2] * fn, v3 = (dt ? o1 : o0)[4 * g + 3] * fn;
                    if (br > 0) { const u32x2 pw = *(const LAS u32x2*)(orow + 64 * dt + 16 * g);
                        v0 += fp * __uint_as_float(pw.x << 16); v1 += fp * __uint_as_float(pw.x & 0xffff0000u); v2 += fp * __uint_as_float(pw.y << 16); v3 += fp * __uint_as_float(pw.y & 0xffff0000u); }
                    u32x2 w; w.x = cvt_pk_bf16(v0, v1); w.y = cvt_pk_bf16(v2, v3);
                    if (br < 2) *(LAS u32x2*)(orow + 64 * dt + 16 * g) = w; else *(u32x2*)(grow + 32 * dt + 8 * g) = w;
                }
        }
        __syncthreads();
    }
}


#define XB_TMO      128
#define XB_XCNT(j)  (256  + 64 * (j))
#define XB_XSUB(j)  (1280 + 64 * (j))
#define XB_XGEN(j)  (2304 + 64 * (j))
#define XB_TOP      3328
#define XB_TOPGEN   3392
#define XCD_BAR_WORDS 3456
#define XB_SPIN_CAP (1u << 20)
DI unsigned xb_ld(unsigned* p)              { return __hip_atomic_load(p, __ATOMIC_RELAXED, __HIP_MEMORY_SCOPE_AGENT); }
DI unsigned xb_add(unsigned* p, unsigned v) { return __hip_atomic_fetch_add(p, v, __ATOMIC_RELAXED, __HIP_MEMORY_SCOPE_AGENT); }
DI unsigned xb_xcc_id() { return (unsigned)__builtin_amdgcn_s_getreg((3 << 11) | 20) & 0xFu; }
#define XB_SPIN(cond, bar) do { unsigned _sp = 0; while (cond) { __builtin_amdgcn_s_sleep(1); \
    if ((++_sp & 255u) == 0u) { if (xb_ld(&(bar)[XB_TMO])) break; if (_sp > XB_SPIN_CAP) { atomicAdd(&(bar)[XB_TMO], 1u); break; } } } } while (0)
struct XcdBarrier { unsigned* bar; unsigned x; volatile LAS unsigned* st; };
DI XcdBarrier xcd_barrier_post(unsigned* bar, volatile LAS unsigned* st) {
    XcdBarrier b; b.bar = bar; b.x = xb_xcc_id(); b.st = st;
    if (threadIdx.x == 0) (void)xb_add(&bar[XB_XCNT(b.x)], 1u);
    return b;
}
DI void xcd_barrier_complete(unsigned* bar, unsigned x, unsigned& nloc, unsigned& nx) {
    const unsigned G = gridDim.x * gridDim.y * gridDim.z;
    unsigned sum, cnt, mine, sp = 0u;
    for (;;) {
        sum = 0u; cnt = 0u; mine = 0u;
#pragma unroll
        for (unsigned j = 0; j < 16; ++j) { const unsigned c = xb_ld(&bar[XB_XCNT(j)]); sum += c; cnt += (c > 0u) ? 1u : 0u; mine = (j == x) ? c : mine; }
        if (sum == G) break;
        __builtin_amdgcn_s_sleep(1);
        if ((++sp & 255u) == 0u) { if (xb_ld(&bar[XB_TMO])) break; if (sp > XB_SPIN_CAP) { atomicAdd(&bar[XB_TMO], 1u); break; } }
    }
    nloc = mine > 0u ? mine : 1u; nx = cnt > 0u ? cnt : 1u;
}
DI void xcd_barrier(const XcdBarrier& b) {
    asm volatile("s_waitcnt vmcnt(0)" ::: "memory");
    __syncthreads();
    if (threadIdx.x == 0) {
        unsigned* bar = b.bar;
        __builtin_amdgcn_s_waitcnt(0);
        unsigned nloc = b.st[0], nx = b.st[1];
        if (nloc == 0u) { xcd_barrier_complete(bar, b.x, nloc, nx); b.st[0] = nloc; b.st[1] = nx; }
        const unsigned old = xb_add(&bar[XB_XSUB(b.x)], 1u);
        const unsigned gen = old / nloc;
        if (old + 1u == (gen + 1u) * nloc) {
            __builtin_amdgcn_fence(__ATOMIC_RELEASE, "agent");
            asm volatile("s_waitcnt vmcnt(0)" ::: "memory");
            const unsigned og = xb_add(&bar[XB_TOP], 1u);
            const unsigned tg = og / nx;
            if (og + 1u == (tg + 1u) * nx) xb_add(&bar[XB_TOPGEN], 1u);
            else XB_SPIN(xb_ld(&bar[XB_TOPGEN]) == tg, bar);
            __builtin_amdgcn_fence(__ATOMIC_ACQUIRE, "agent");
            xb_add(&bar[XB_XGEN(b.x)], 1u);
            asm volatile("s_waitcnt vmcnt(0)" ::: "memory");
        } else {
            XB_SPIN(xb_ld(&bar[XB_XGEN(b.x)]) == gen, bar);
            __builtin_amdgcn_fence(__ATOMIC_ACQUIRE, "agent");
            asm volatile("s_waitcnt vmcnt(0)" ::: "memory");
        }
    }
    __syncthreads();
}

__global__ void __launch_bounds__(NTHR, 2) fwd_megakernel(Params p) {
    extern __shared__ __attribute__((aligned(16))) unsigned char smem[];
    LAS unsigned char* lds = (LAS unsigned char*)smem;
    cg::grid_group grid = cg::this_grid();
    const int tid = threadIdx.x;
    unsigned char* ws = p.ws;
    volatile LAS unsigned* bst = (volatile LAS unsigned*)(lds + 131072);
    if (tid < 4) bst[tid] = 0u;
    __syncthreads();
    const XcdBarrier xbar = xcd_barrier_post((unsigned*)(ws + WS_BAR), bst);

    prelude_phase(p, lds, tid);
    grid.sync();
    norm0_phase(p.x, p.norm_g, (const float*)(ws + WS_MOD) + DM, (bf16_t*)(ws + WS_Y), (float*)(ws + WS_SSQ), tid);
    bias_phase(ws, tid);
    xcd_barrier(xbar);

    for (int l = 0; l < 2; ++l) {
        for (int sb = 0; sb < 3; ++sb) {
            ws = launder_p(ws);
            const float* mod = (const float*)(ws + WS_MOD);
            const float* modl = mod + (size_t)l * 8 * (NADA * DM);
            bf16_t* Y = (bf16_t*)(ws + WS_Y); bf16_t* PG = (bf16_t*)(ws + WS_PG);
            const int slot = l * 3 + sb;
            float* ssq = (float*)(ws + WS_SSQ);
            const float* hin = (slot == 0) ? p.x : p.out;
            const bf16_t* A2; const bf16_t* B2; int K2; float gsc;
            if (sb != 1) {
                const int lf = l * 2 + (sb >> 1);
                pg8::Gemm g{Y, (const bf16_t*)(ws + WS_UP + (size_t)lf * SZ_UP), MTOK, 2 * FF, DM};
                pg8::StaticOrder S; S.init(MTOK, 2 * FF, (int)gridDim.x, (int)blockIdx.x);
                EpiSwiglu E{PG, ssq + (size_t)slot * MTOK, (const float*)(ws + WS_BUP) + (size_t)lf * 8 * (2 * FF)};
                pg8::gemm_phase<EpiSwiglu>(lds, g, S, E);
                xcd_barrier(xbar);
                A2 = PG; B2 = (const bf16_t*)(ws + WS_DN + (size_t)lf * SZ_DN); K2 = FF; gsc = 0.5f;
            } else {
                pg8::Gemm g{Y, (const bf16_t*)(ws + WS_IN + (size_t)l * SZ_IN), MTOK, INW, DM};
                pg8::StaticOrder S; S.init(MTOK, INW, (int)gridDim.x, (int)blockIdx.x);
                EpiIn E{PG, (const float*)(ws + WS_ROPE), ssq + (size_t)slot * MTOK, (const float*)(ws + WS_BIN) + (size_t)l * 8 * INW};
                pg8::gemm_phase<EpiIn>(lds, g, S, E);
                xcd_barrier(xbar);
                for (int it = blockIdx.x; it < 1024; it += gridDim.x) sgu_item(p, l, it, lds, tid);
                for (int it = blockIdx.x; it < 512; it += gridDim.x) attn_item(p, it, lds, tid);
                xcd_barrier(xbar);
                A2 = (const bf16_t*)(ws + WS_MIX); B2 = (const bf16_t*)(ws + WS_OUT + (size_t)l * SZ_OUT); K2 = DM; gsc = 1.0f;
            }
            {
                const int ns = slot + 1, nl = ns / 3, nsb = ns % 3;
                pg8::Gemm g{A2, B2, MTOK, DM, K2};
                pg8::StaticOrder S; S.init(MTOK, DM, (int)gridDim.x, (int)blockIdx.x);
                EpiResid E{hin, p.out, modl + (3 * sb + 2) * DM, (ns < 6) ? Y : (bf16_t*)nullptr, ssq + (size_t)ns * MTOK,
                           p.norm_g + (size_t)(ns < 6 ? ns : 0) * DM, mod + (size_t)(ns < 6 ? nl : 0) * 8 * (NADA * DM) + (3 * nsb + 1) * DM, gsc, 0.f};
                pg8::gemm_phase<EpiResid>(lds, g, S, E);
                xcd_barrier(xbar);
            }
        }
    }
    final_norm_phase(p.out, p.final_g, (const float*)(ws + WS_SSQ) + (size_t)6 * MTOK, tid);
}

constexpr int LDS_BYTES = 131072 + 16;
extern "C" void kernel_launch(void* const* d_in, const int* in_sizes, int n_in, void* d_out, int out_size, void* d_ws, size_t ws_size, hipStream_t stream) {
    static int grid_blocks = 0;
    if (!grid_blocks) {
        int dev = 0, cus = 0, per_cu = 0;
        hipGetDevice(&dev);
        hipDeviceGetAttribute(&cus, hipDeviceAttributeMultiprocessorCount, dev);
        hipFuncSetAttribute((const void*)fwd_megakernel, hipFuncAttributeMaxDynamicSharedMemorySize, LDS_BYTES);
        hipOccupancyMaxActiveBlocksPerMultiprocessor(&per_cu, (const void*)fwd_megakernel, NTHR, LDS_BYTES);
        if (per_cu < 1) per_cu = 1;
        grid_blocks = cus * per_cu;
        if (ws_size < WS_END) fprintf(stderr, "kernel_launch: workspace too small (%zu < %zu)\n", ws_size, (size_t)WS_END);
    }
    Params p{};
    p.x = (const float*)d_in[0]; p.c = (const float*)d_in[1]; p.ada_w = (const float*)d_in[2]; p.ada_b = (const float*)d_in[3]; p.norm_g = (const float*)d_in[4];
    p.f1g = (const float*)d_in[5]; p.f1u = (const float*)d_in[6]; p.f1d = (const float*)d_in[7]; p.f2g = (const float*)d_in[8]; p.f2u = (const float*)d_in[9]; p.f2d = (const float*)d_in[10];
    p.w_in = (const float*)d_in[11]; p.sgu_ln_g = (const float*)d_in[12]; p.sgu_ln_b = (const float*)d_in[13]; p.sgu_w = (const float*)d_in[14]; p.sgu_b = (const float*)d_in[15];
    p.w_out = (const float*)d_in[16]; p.final_g = (const float*)d_in[17];
    p.out = (float*)d_out; p.ws = (unsigned char*)d_ws;
    (void)hipMemsetAsync((unsigned char*)d_ws + WS_BAR, 0, ZERO_BYTES, stream);
    void* args[] = {&p};
    hipError_t e = hipLaunchCooperativeKernel((const void*)fwd_megakernel, dim3(grid_blocks), dim3(NTHR), args, LDS_BYTES, stream);
    if (e != hipSuccess) fprintf(stderr, "cooperative launch failed: %s (grid %d)\n", hipGetErrorString(e), grid_blocks);
}
```

```cpp
#include <hip/hip_runtime.h>
#include <hip/hip_cooperative_groups.h>
#include <cstdio>
namespace cg = cooperative_groups;

#define LAS __attribute__((address_space(3)))
#define DI __device__ __forceinline__
typedef unsigned short bf16_t;
typedef short bf16x8 __attribute__((ext_vector_type(8)));
typedef short s16x4 __attribute__((ext_vector_type(4)));
typedef float f32x4 __attribute__((ext_vector_type(4)));
typedef float f32x2 __attribute__((ext_vector_type(2)));
typedef float f32x16 __attribute__((ext_vector_type(16)));
typedef unsigned u32x4 __attribute__((ext_vector_type(4)));
typedef unsigned u32x2 __attribute__((ext_vector_type(2)));

constexpr int DM = 1024, NB = 8, SEQ = 4096, MTOK = NB * SEQ, FF = 2816, INW = 2560, NADA = 9;
constexpr int NTHR = 512;
constexpr float EPS = 1e-6f;

constexpr size_t SZ_UP = (size_t)2 * FF * DM * 2;
constexpr size_t SZ_DN = (size_t)DM * FF * 2;
constexpr size_t SZ_IN = (size_t)INW * DM * 2;
constexpr size_t SZ_OUT = (size_t)DM * DM * 2;
constexpr size_t WS_UP = 0;
constexpr size_t WS_DN = WS_UP + 4 * SZ_UP;
constexpr size_t WS_IN = WS_DN + 4 * SZ_DN;
constexpr size_t WS_OUT = WS_IN + 2 * SZ_IN;
constexpr size_t WS_SGUW = WS_OUT + 2 * SZ_OUT;
constexpr size_t WS_MOD = WS_SGUW + (size_t)2 * 4 * 128 * 128 * 2;
constexpr size_t WS_ROPE = WS_MOD + (size_t)2 * 8 * 9216 * 4;
constexpr size_t WS_Y = WS_ROPE + (size_t)4096 * 32 * 8;
constexpr size_t WS_PG = WS_Y + (size_t)MTOK * DM * 2;
constexpr size_t WS_MIX = WS_PG + (size_t)MTOK * FF * 2;
constexpr size_t WS_H = WS_MIX + (size_t)MTOK * DM * 2;
constexpr size_t WS_BUP = WS_H + (size_t)MTOK * DM * 2;
constexpr size_t WS_BIN = WS_BUP + (size_t)4 * 8 * 2 * FF * 4;
constexpr size_t WS_BAR = WS_BIN + (size_t)2 * 8 * INW * 4;
constexpr size_t WS_SSQ = WS_BAR + 16384;
constexpr size_t ZERO_BYTES = 16384 + (size_t)7 * MTOK * 4;
constexpr size_t WS_END = WS_BAR + ZERO_BYTES;

struct Params {
    const float *x, *c, *ada_w, *ada_b, *norm_g, *f1g, *f1u, *f1d, *f2g, *f2u, *f2d, *w_in, *sgu_ln_g, *sgu_ln_b, *sgu_w, *sgu_b, *w_out, *final_g;
    float* out; unsigned char* ws;
};

DI int launder_v(int x) { asm volatile("" : "+v"(x)); return x; }
template <class T> DI T* launder_p(T* q) { size_t z = 0; asm volatile("" : "+s"(z)); return (T*)((unsigned char*)q + z); }
DI float bf2f(unsigned short v) { return __uint_as_float((unsigned)v << 16); }
DI unsigned short f2bf(float f) { unsigned u = __float_as_uint(f); u += 0x7fffu + ((u >> 16) & 1u); return (unsigned short)(u >> 16); }
DI unsigned cvt_pk_bf16(float lo, float hi) { unsigned r; asm("v_cvt_pk_bf16_f32 %0, %1, %2" : "=v"(r) : "v"(lo), "v"(hi)); return r; }
DI float fast_exp2(float x) { return __builtin_amdgcn_exp2f(x); }
DI float fast_rcp(float x) { return __builtin_amdgcn_rcpf(x); }
DI float silu_f(float x) { return x * fast_rcp(1.0f + fast_exp2(-1.4426950409f * x)); }
DI float gelu_tanh_f(float x) { const float t = 0.7978845608f * (x + 0.044715f * x * x * x); return x * fast_rcp(1.0f + fast_exp2(-2.8853900818f * t)); }

namespace pg8 {
constexpr int BM = 256, BK = 64, HALF = 128, HTB = HALF * BK * 2, STAGE_BYTES = 8 * HTB, NXCD = 8, WGM = 8;
DI int lds_byte(int r, int c) { const int st = (r >> 4) * 2 + (c >> 5), rr = r & 15, cc = c & 31, ob = rr * 64 + cc * 2; return st * 1024 + (ob ^ (((ob >> 9) & 1) << 5)); }
DI void stage_rc(int b, int& R, int& C) { const int st = b / 1024, sb = b % 1024, swz = sb ^ (((sb >> 9) & 1) << 5); R = (st >> 1) * 16 + swz / 64; C = (st & 1) * 32 + (swz % 64) / 2; }
DI int perm32(int rho) { const int n = rho >> 4, i = rho & 15; return 8 * (i >> 2) + 4 * n + (i & 3); }
struct Unit { int pm, pn; };
struct Gemm { const bf16_t* A; const bf16_t* Bt; int M, N, K; };
struct StaticOrder {
    int nM, nN, nwg, G, c;
    DI void init(int M, int N, int G_, int c_) { nM = M / BM; nN = N / BM; nwg = nM * nN; G = G_; c = c_; }
    DI bool next(int i, Unit& u) const {
        const long L = (long)i * G + c; if (L >= nwg) return false;
        int wgid = (int)L; { const int q = nwg / NXCD, r = nwg % NXCD, xcd = wgid % NXCD, off = wgid / NXCD; wgid = (xcd < r ? xcd * (q + 1) : r * (q + 1) + (xcd - r) * q) + off; }
        const int nig = WGM * nN, gid = wgid / nig, fm = gid * WGM, gsz = (nM - fm) < WGM ? (nM - fm) : WGM;
        u.pm = fm + ((wgid % nig) % gsz); u.pn = (wgid % nig) / gsz; return true;
    }
};

template <class Epi>
DI void gemm_phase(LAS unsigned char* lds, const Gemm g, const StaticOrder& S, const Epi& E) {
    const int tid = launder_v(threadIdx.x), wid = __builtin_amdgcn_readfirstlane(tid >> 6), lane = tid & 63, wr = wid >> 2, wc = wid & 3, fr = lane & 15, fq = lane >> 4;
    const int K = g.K, nt = K / BK;
    unsigned voffA[2], voffB[2];
#pragma unroll
    for (int i = 0; i < 2; ++i) { int R, C; stage_rc(tid * 16 + i * 8192, R, C); const int Rb = Epi::PERM ? ((R & ~31) + perm32(R & 31)) : R;
        voffA[i] = (unsigned)(R * K + C) * 2u; voffB[i] = (unsigned)(Rb * K + C) * 2u; }
    const size_t kstep = (size_t)(BK * 2);
    const size_t hstep = (size_t)HALF * K * 2;
    const size_t tstep = 2 * hstep;
    const unsigned ldsw = (unsigned)wid * 1024u;
    const int aoff = lds_byte(wr * 64 + fr, fq * 8), boff = lds_byte(wc * 32 + fr, fq * 8);
#define PG8_SA(b, h) (((b) * 2 + (h)) * HTB)
#define PG8_SB(b, h) ((4 + (b) * 2 + (h)) * HTB)
#define PG8_STAGE(bufoff, gbase, voff) do { _Pragma("unroll") for (int _i = 0; _i < 2; ++_i) \
        __builtin_amdgcn_global_load_lds((const unsigned*)((const char*)(gbase) + (voff)[_i]), (LAS unsigned*)(lds + (bufoff) + ldsw + _i * 8192), 16, 0, 0); } while (0)
#define PG8_LDA(dst, b, h) do { _Pragma("unroll") for (int m = 0; m < 4; ++m) _Pragma("unroll") for (int k = 0; k < 2; ++k) dst[m][k] = *(const LAS bf16x8*)(lds + PG8_SA(b, h) + aoff + m * 2048 + k * 1024); } while (0)
#define PG8_LDB(dst, b, h) do { _Pragma("unroll") for (int n = 0; n < 2; ++n) _Pragma("unroll") for (int k = 0; k < 2; ++k) dst[n][k] = *(const LAS bf16x8*)(lds + PG8_SB(b, h) + boff + n * 2048 + k * 1024); } while (0)
#define PG8_MMA(ai, bj, At, Bt) do { __builtin_amdgcn_s_setprio(1); _Pragma("unroll") for (int m = 0; m < 4; ++m) _Pragma("unroll") for (int n = 0; n < 2; ++n) _Pragma("unroll") for (int k = 0; k < 2; ++k) \
        acc[ai][bj][m][n] = __builtin_amdgcn_mfma_f32_16x16x32_bf16(Bt[n][k], At[m][k], acc[ai][bj][m][n], 0, 0, 0); __builtin_amdgcn_s_setprio(0); } while (0)
#define PG8_WAIT_V(n) asm volatile("s_waitcnt vmcnt(" #n ")" ::: "memory")
#define PG8_WAIT_L(n) asm volatile("s_waitcnt lgkmcnt(" #n ")" ::: "memory")
#define PG8_BAR __builtin_amdgcn_s_barrier()
#define PG8_SCHED __builtin_amdgcn_sched_barrier(0)
    Unit cur, nxt; int ui = 0;
    if (!S.next(0, cur)) return;
    f32x4 acc[2][2][4][2];
#pragma unroll
    for (int a = 0; a < 2; ++a)
#pragma unroll
        for (int b = 0; b < 2; ++b)
#pragma unroll
            for (int m = 0; m < 4; ++m)
#pragma unroll
                for (int n = 0; n < 2; ++n) acc[a][b][m][n] = (f32x4){0.f, 0.f, 0.f, 0.f};
    bf16x8 At[4][2], B0[2][2], B1[2][2];
    const char* cA = (const char*)g.A + (size_t)cur.pm * tstep; const char* cB = (const char*)g.Bt + (size_t)cur.pn * tstep;
    PG8_STAGE(PG8_SB(0, 0), cB, voffB); PG8_STAGE(PG8_SA(0, 0), cA, voffA); PG8_STAGE(PG8_SB(0, 1), cB + hstep, voffB); PG8_STAGE(PG8_SA(0, 1), cA + hstep, voffA);
    if (wr == 1) PG8_BAR;
    PG8_WAIT_V(4); PG8_BAR;
    PG8_STAGE(PG8_SB(1, 0), cB + kstep, voffB); PG8_STAGE(PG8_SA(1, 0), cA + kstep, voffA); PG8_STAGE(PG8_SB(1, 1), cB + hstep + kstep, voffB);
    PG8_WAIT_V(6); PG8_BAR;
    for (;;) {
        const bool has_next = S.next(ui + 1, nxt);
        const char* nA = has_next ? (const char*)g.A + (size_t)nxt.pm * tstep : cA; const char* nB = has_next ? (const char*)g.Bt + (size_t)nxt.pn * tstep : cB;
        for (int t = 0; t < nt; t += 2) {
            const bool last = (t == nt - 2);
            const char* a1 = cA + (size_t)(t + 1) * kstep;
            const char* a2 = last ? nA : cA + (size_t)(t + 2) * kstep; const char* b2 = last ? nB : cB + (size_t)(t + 2) * kstep;
            const char* a3 = a2 + kstep; const char* b3 = b2 + kstep;
            PG8_LDB(B0, 0, 0); PG8_SCHED; PG8_LDA(At, 0, 0); PG8_STAGE(PG8_SA(1, 1), a1 + hstep, voffA);
            PG8_WAIT_L(8); PG8_BAR; PG8_WAIT_L(0); PG8_MMA(0, 0, At, B0); PG8_BAR; PG8_SCHED;
            PG8_LDB(B1, 0, 1); PG8_STAGE(PG8_SB(0, 0), b2, voffB);
            PG8_BAR; PG8_WAIT_L(0); PG8_MMA(0, 1, At, B1); PG8_BAR;
            PG8_LDA(At, 0, 1); PG8_STAGE(PG8_SA(0, 0), a2, voffA);
            PG8_BAR; PG8_WAIT_L(0); PG8_MMA(1, 0, At, B0); PG8_BAR; PG8_SCHED;
            PG8_STAGE(PG8_SB(0, 1), b2 + hstep, voffB);
            PG8_WAIT_V(6); PG8_BAR; PG8_MMA(1, 1, At, B1); PG8_BAR;
            PG8_LDB(B0, 1, 0); PG8_SCHED; PG8_LDA(At, 1, 0); PG8_STAGE(PG8_SA(0, 1), a2 + hstep, voffA);
            PG8_WAIT_L(8); PG8_BAR; PG8_WAIT_L(0); PG8_MMA(0, 0, At, B0); PG8_BAR; PG8_SCHED;
            PG8_LDB(B1, 1, 1); PG8_STAGE(PG8_SB(1, 0), b3, voffB);
            PG8_BAR; PG8_WAIT_L(0); PG8_MMA(0, 1, At, B1); PG8_BAR;
            PG8_LDA(At, 1, 1); PG8_STAGE(PG8_SA(1, 0), a3, voffA);
            PG8_BAR; PG8_WAIT_L(0); PG8_MMA(1, 0, At, B0); PG8_BAR; PG8_SCHED;
            PG8_STAGE(PG8_SB(1, 1), b3 + hstep, voffB);
            PG8_WAIT_V(6); PG8_BAR; PG8_MMA(1, 1, At, B1); PG8_BAR;
        }
        E(acc, cur, wr, wc, fr, fq);
        if (!has_next) break;
#pragma unroll
        for (int a = 0; a < 2; ++a)
#pragma unroll
            for (int b = 0; b < 2; ++b)
#pragma unroll
                for (int m = 0; m < 4; ++m)
#pragma unroll
                    for (int n = 0; n < 2; ++n) acc[a][b][m][n] = (f32x4){0.f, 0.f, 0.f, 0.f};
        cur = nxt; cA = nA; cB = nB; ++ui;
    }
    PG8_WAIT_V(0);
    if (wr == 0) PG8_BAR;
    PG8_BAR;
#undef PG8_SA
#undef PG8_SB
#undef PG8_STAGE
#undef PG8_LDA
#undef PG8_LDB
#undef PG8_MMA
#undef PG8_WAIT_V
#undef PG8_WAIT_L
#undef PG8_BAR
#undef PG8_SCHED
}
}

struct EpiSwiglu {
    static constexpr bool PERM = true;
    bf16_t* G; const float* ssq; const float* bias;
    DI void operator()(const f32x4 (&acc)[2][2][4][2], const pg8::Unit& u, int wr, int wc, int fr, int fq) const {
        const int row0 = u.pm * 256 + wr * 64 + fr, col0 = u.pn * 128 + wc * 32 + 8 * fq, b = (u.pm * 256) / SEQ;
        const float* bp = bias + (size_t)b * (2 * FF) + u.pn * 256 + wc * 32 + 8 * fq;
        const f32x4 bg0 = *(const f32x4*)bp, bg1 = *(const f32x4*)(bp + 4), bu0 = *(const f32x4*)(bp + 128), bu1 = *(const f32x4*)(bp + 132);
        float sq[8];
#pragma unroll
        for (int i = 0; i < 8; ++i) sq[i] = ssq[row0 + (i >> 2) * 128 + (i & 3) * 16];
#pragma unroll
        for (int ai = 0; ai < 2; ++ai)
#pragma unroll
            for (int m = 0; m < 4; ++m) {
                bf16_t* rowp = G + (size_t)(row0 + ai * 128 + m * 16) * FF + col0;
                const float rstd = rsqrtf(sq[ai * 4 + m] * (1.0f / DM) + EPS);
                const f32x4 g0 = acc[ai][0][m][0] * rstd + bg0, g1 = acc[ai][0][m][1] * rstd + bg1, u0 = acc[ai][1][m][0] * rstd + bu0, u1 = acc[ai][1][m][1] * rstd + bu1;
                u32x4 w;
                w.x = cvt_pk_bf16(silu_f(g0[0]) * u0[0], silu_f(g0[1]) * u0[1]); w.y = cvt_pk_bf16(silu_f(g0[2]) * u0[2], silu_f(g0[3]) * u0[3]);
                w.z = cvt_pk_bf16(silu_f(g1[0]) * u1[0], silu_f(g1[1]) * u1[1]); w.w = cvt_pk_bf16(silu_f(g1[2]) * u1[2], silu_f(g1[3]) * u1[3]);
                *(u32x4*)rowp = w;
            }
    }
};
struct EpiResid {
    static constexpr bool PERM = true;
    const bf16_t* hin; bf16_t* hout; const float* gate;
    bf16_t* ynext; float* ssqn; const float* gnext; const float* scnext;
    float gscale, pad_;
    DI void operator()(const f32x4 (&acc)[2][2][4][2], const pg8::Unit& u, int wr, int wc, int fr, int fq) const {
        const int row0 = u.pm * 256 + wr * 64 + fr, col0 = u.pn * 256 + wc * 32 + 8 * fq, b = (u.pm * 256) / SEQ;
        const bool has_y = ynext != nullptr;
        f32x4 gv[2][2], gm[2][2];
#pragma unroll
        for (int bj = 0; bj < 2; ++bj)
#pragma unroll
            for (int n = 0; n < 2; ++n) {
                gv[bj][n] = *(const f32x4*)(gate + (size_t)b * (NADA * DM) + col0 + bj * 128 + n * 4) * gscale;
                gm[bj][n] = *(const f32x4*)(gnext + col0 + bj * 128 + n * 4) * (*(const f32x4*)(scnext + (size_t)b * (NADA * DM) + col0 + bj * 128 + n * 4) + 1.0f);
            }
        u32x4 hb[3][2];
#pragma unroll
        for (int r = 0; r < 3; ++r) { const size_t off = (size_t)(row0 + r * 16) * DM + col0;
#pragma unroll
          for (int bj = 0; bj < 2; ++bj) hb[r][bj] = *(const u32x4*)(hin + off + bj * 128); }
#pragma unroll
        for (int it = 0; it < 8; ++it) {
            const int ai = it >> 2, m = it & 3;
            const size_t off = (size_t)(row0 + ai * 128 + m * 16) * DM + col0;
            u32x4 wh[2], wy[2]; float rs = 0.f;
#pragma unroll
            for (int bj = 0; bj < 2; ++bj) {
                const u32x4 q = hb[it % 3][bj];
                f32x4 h0 = {__uint_as_float(q.x << 16), __uint_as_float(q.x & 0xffff0000u), __uint_as_float(q.y << 16), __uint_as_float(q.y & 0xffff0000u)};
                f32x4 h1 = {__uint_as_float(q.z << 16), __uint_as_float(q.z & 0xffff0000u), __uint_as_float(q.w << 16), __uint_as_float(q.w & 0xffff0000u)};
                h0 += gv[bj][0] * acc[ai][bj][m][0]; h1 += gv[bj][1] * acc[ai][bj][m][1];
                rs += h0[0] * h0[0] + h0[1] * h0[1] + h0[2] * h0[2] + h0[3] * h0[3] + h1[0] * h1[0] + h1[1] * h1[1] + h1[2] * h1[2] + h1[3] * h1[3];
                wh[bj].x = cvt_pk_bf16(h0[0], h0[1]); wh[bj].y = cvt_pk_bf16(h0[2], h0[3]); wh[bj].z = cvt_pk_bf16(h1[0], h1[1]); wh[bj].w = cvt_pk_bf16(h1[2], h1[3]);
                const f32x4 a0 = h0 * gm[bj][0], a1 = h1 * gm[bj][1];
                wy[bj].x = cvt_pk_bf16(a0[0], a0[1]); wy[bj].y = cvt_pk_bf16(a0[2], a0[3]); wy[bj].z = cvt_pk_bf16(a1[0], a1[1]); wy[bj].w = cvt_pk_bf16(a1[2], a1[3]);
            }
            __builtin_amdgcn_sched_barrier(0);
            if (it < 5) { const size_t off2 = (size_t)(row0 + ((it + 3) >> 2) * 128 + ((it + 3) & 3) * 16) * DM + col0;
#pragma unroll
                for (int bj = 0; bj < 2; ++bj) hb[it % 3][bj] = *(const u32x4*)(hin + off2 + bj * 128); }
            __builtin_amdgcn_sched_barrier(0);
#pragma unroll
            for (int bj = 0; bj < 2; ++bj) {
                *(u32x4*)(hout + off + bj * 128) = wh[bj];
                if (has_y) *(u32x4*)(ynext + off + bj * 128) = wy[bj];
            }
            rs += __shfl_xor(rs, 16); rs += __shfl_xor(rs, 32);
            if (fq == 0) (void)__hip_atomic_fetch_add(ssqn + row0 + ai * 128 + m * 16, rs, __ATOMIC_RELAXED, __HIP_MEMORY_SCOPE_AGENT);
        }
    }
};
struct EpiIn {
    static constexpr bool PERM = true;
    bf16_t* P; const float* rope; const float* ssq; const float* bias;
    DI void operator()(const f32x4 (&acc)[2][2][4][2], const pg8::Unit& u, int wr, int wc, int fr, int fq) const {
        const int row0 = u.pm * 256 + wr * 64 + fr, col0 = u.pn * 256 + wc * 32 + 8 * fq, kind = u.pn >> 1, b = (u.pm * 256) / SEQ;
        const int i0 = 16 * (wc & 1) + 4 * fq;
        const bool is_rope = (kind == 2 || kind == 3);
        const float* bp = bias + (size_t)b * INW + col0;
        const f32x4 bv00 = *(const f32x4*)bp, bv01 = *(const f32x4*)(bp + 4), bv10 = *(const f32x4*)(bp + 128), bv11 = *(const f32x4*)(bp + 132);
        float sq[8];
#pragma unroll
        for (int i = 0; i < 8; ++i) sq[i] = ssq[row0 + (i >> 2) * 128 + (i & 3) * 16];
        const float qs = (kind == 2) ? 0.125f * 1.4426950409f : 1.0f;
        f32x4 cs0 = {1.f, 0.f, 1.f, 0.f}, cs1 = {1.f, 0.f, 1.f, 0.f};
        if (is_rope) { const f32x4* rp = (const f32x4*)(rope + ((size_t)(row0 & (SEQ - 1)) * 32 + i0) * 2); cs0 = rp[0]; cs1 = rp[1]; }
#pragma unroll
        for (int it = 0; it < 8; ++it) {
            const int ai = it >> 2, m = it & 3;
            const int row = row0 + ai * 128 + m * 16;
            bf16_t* rowp = P + (size_t)row * INW + col0;
            const float rstd = rsqrtf(sq[it] * (1.0f / DM) + EPS);
            f32x4 cn0 = cs0, cn1 = cs1;
            if (is_rope && it < 7) { const int row2 = row0 + ((it + 1) >> 2) * 128 + ((it + 1) & 3) * 16;
                const f32x4* rp = (const f32x4*)(rope + ((size_t)(row2 & (SEQ - 1)) * 32 + i0) * 2); cn0 = rp[0]; cn1 = rp[1]; }
            __builtin_amdgcn_sched_barrier(0);
#pragma unroll
            for (int bj = 0; bj < 2; ++bj) {
                f32x4 v0 = acc[ai][bj][m][0] * rstd + (bj ? bv10 : bv00), v1 = acc[ai][bj][m][1] * rstd + (bj ? bv11 : bv01);
                if (kind <= 1) {
#pragma unroll
                    for (int j = 0; j < 4; ++j) { v0[j] = gelu_tanh_f(v0[j]); v1[j] = gelu_tanh_f(v1[j]); }
                } else if (kind <= 3) {
#pragma unroll
                    for (int j = 0; j < 4; ++j) { const float cj = (j < 2 ? cs0 : cs1)[(j & 1) * 2], sj = (j < 2 ? cs0 : cs1)[(j & 1) * 2 + 1];
                        const float x1 = v0[j], x2 = v1[j]; v0[j] = (x1 * cj - x2 * sj) * qs; v1[j] = (x2 * cj + x1 * sj) * qs; }
                }
                u32x4 w; w.x = cvt_pk_bf16(v0[0], v0[1]); w.y = cvt_pk_bf16(v0[2], v0[3]); w.z = cvt_pk_bf16(v1[0], v1[1]); w.w = cvt_pk_bf16(v1[2], v1[3]);
                *(u32x4*)(rowp + bj * 128) = w;
            }
            cs0 = cn0; cs1 = cn1;
        }
    }
};

DI void tr_tile(const float* src, int ld_src, int srccol0, int k0, bf16_t* dst, int ld_dst, int n0, bool rperm, LAS float* tile, int tid) {
#pragma unroll
    for (int i = 0; i < 2; ++i) {
        const int idx = tid + i * NTHR, row = idx >> 4, c4 = idx & 15;
        const f32x4 v = *(const f32x4*)(src + (size_t)(k0 + row) * ld_src + srccol0 + c4 * 4);
        LAS float* t = tile + row * 65 + c4 * 4; t[0] = v[0]; t[1] = v[1]; t[2] = v[2]; t[3] = v[3];
    }
    __syncthreads();
    const int p = tid >> 3, kc = (tid & 7) * 8;
    const int pp = rperm ? (4 * (p >> 3) + (p & 3) + 32 * ((p >> 2) & 1)) : p;
    float v[8];
#pragma unroll
    for (int j = 0; j < 8; ++j) v[j] = tile[(kc + j) * 65 + pp];
    u32x4 w; w.x = cvt_pk_bf16(v[0], v[1]); w.y = cvt_pk_bf16(v[2], v[3]); w.z = cvt_pk_bf16(v[4], v[5]); w.w = cvt_pk_bf16(v[6], v[7]);
    *(u32x4*)(dst + (size_t)(n0 + p) * ld_dst + k0 + kc) = w;
    __syncthreads();
}

constexpr int IT_MOD = 288;
constexpr int IT_ROPE = 256, IT_SGUW = 256;
constexpr int T_UP = 88 * 16, T_DN = 16 * 44, T_IN = 40 * 16, T_OUT = 16 * 16;
constexpr int IT_UP0 = IT_MOD + IT_ROPE + IT_SGUW, IT_DN0 = IT_UP0 + 4 * T_UP, IT_IN0 = IT_DN0 + 4 * T_DN, IT_OUT0 = IT_IN0 + 2 * T_IN, IT_END = IT_OUT0 + 2 * T_OUT;

DI void prelude_phase(const Params& p, LAS unsigned char* lds, int tid) {
    unsigned char* ws = p.ws;
    for (int it = blockIdx.x; it < IT_END; it += gridDim.x) {
        if (it < IT_MOD) {
            const int l = it / 144, cb = it % 144;
            LAS float* s = (LAS float*)lds; LAS float* red = (LAS float*)(lds + 32768);
            for (int i = tid; i < NB * DM; i += NTHR) s[i] = silu_f(p.c[i]);
            __syncthreads();
            const int cp = tid & 31, kg = tid >> 5;
            float a[8][2];
#pragma unroll
            for (int b = 0; b < 8; ++b) { a[b][0] = 0.f; a[b][1] = 0.f; }
            const float* w = p.ada_w + (size_t)l * DM * (NADA * DM) + (size_t)(kg * 64) * (NADA * DM) + cb * 64 + cp * 2;
#pragma unroll 4
            for (int k = 0; k < 64; ++k) {
                const f32x2 wv = *(const f32x2*)(w + (size_t)k * (NADA * DM));
#pragma unroll
                for (int b = 0; b < 8; ++b) { const float sv = s[b * DM + kg * 64 + k]; a[b][0] += sv * wv.x; a[b][1] += sv * wv.y; }
            }
#pragma unroll
            for (int b = 0; b < 8; ++b) { red[(kg * 8 + b) * 64 + cp * 2] = a[b][0]; red[(kg * 8 + b) * 64 + cp * 2 + 1] = a[b][1]; }
            __syncthreads();
            { const int b = tid >> 6, col = tid & 63; float sum = 0.f;
#pragma unroll
              for (int g = 0; g < 16; ++g) sum += red[(g * 8 + b) * 64 + col];
              const int n = cb * 64 + col;
              ((float*)(ws + WS_MOD))[((size_t)l * 8 + b) * (NADA * DM) + n] = sum + p.ada_b[(size_t)l * (NADA * DM) + n]; }
            __syncthreads();
        } else if (it < IT_MOD + IT_ROPE) {
            const int idx = (it - IT_MOD) * NTHR + tid, pos = idx >> 5, i = idx & 31;
            const float inv = exp2f(-(float)i * (13.287712379549449f / 32.0f));
            const float ang = (float)pos * inv;
            const double rev = (double)ang * 0.15915494309189535;
            const float fr = (float)(rev - floor(rev));
            f32x2 cs; cs.x = __builtin_amdgcn_cosf(fr); cs.y = __builtin_amdgcn_sinf(fr);
            ((f32x2*)(ws + WS_ROPE))[idx] = cs;
        } else if (it < IT_UP0) {
            const int idx = (it - IT_MOD - IT_ROPE) * NTHR + tid, j = idx & 127, i = (idx >> 7) & 127;
            ((bf16_t*)(ws + WS_SGUW))[idx] = (j <= i) ? f2bf(p.sgu_w[idx]) : (bf16_t)0;
        } else if (it < IT_DN0) {
            const int r = it - IT_UP0, lf = r / T_UP, t = r % T_UP, nb = t >> 4, kb = t & 15, l = lf >> 1, f = lf & 1;
            const int n0 = nb * 64, tl = n0 >> 8, half = (n0 >> 7) & 1, j0 = n0 & 127;
            const float* src = (f ? (half ? p.f2u : p.f2g) : (half ? p.f1u : p.f1g)) + (size_t)l * DM * FF;
            tr_tile(src, FF, tl * 128 + j0, kb * 64, (bf16_t*)(ws + WS_UP + (size_t)lf * SZ_UP), DM, n0, false, (LAS float*)lds, tid);
        } else if (it < IT_IN0) {
            const int r = it - IT_DN0, lf = r / T_DN, t = r % T_DN, nb = t / 44, kb = t % 44, l = lf >> 1, f = lf & 1;
            const float* src = (f ? p.f2d : p.f1d) + (size_t)l * FF * DM;
            tr_tile(src, DM, nb * 64, kb * 64, (bf16_t*)(ws + WS_DN + (size_t)lf * SZ_DN), FF, nb * 64, false, (LAS float*)lds, tid);
        } else if (it < IT_OUT0) {
            const int r = it - IT_IN0, l = r / T_IN, t = r % T_IN, nb = t >> 4, kb = t & 15, n0 = nb * 64;
            tr_tile(p.w_in + (size_t)l * DM * INW, INW, n0, kb * 64, (bf16_t*)(ws + WS_IN + (size_t)l * SZ_IN), DM, n0, (n0 >= 1024 && n0 < 2048), (LAS float*)lds, tid);
        } else {
            const int r = it - IT_OUT0, l = r / T_OUT, t = r % T_OUT, nb = t >> 4, kb = t & 15;
            tr_tile(p.w_out + (size_t)l * DM * DM, DM, nb * 64, kb * 64, (bf16_t*)(ws + WS_OUT + (size_t)l * SZ_OUT), DM, nb * 64, false, (LAS float*)lds, tid);
        }
    }
}

DI float wave_sum(float v) {
#pragma unroll
    for (int o = 32; o >= 1; o >>= 1) v += __shfl_xor(v, o);
    return v;
}
DI void norm0_phase(const float* h, const float* g, const float* sc, bf16_t* y, float* ssq, bf16_t* hb, int tid) {
    tid = launder_v(tid);
    const int wave = tid >> 6, lane = tid & 63;
    for (int row = blockIdx.x * 8 + wave; row < MTOK; row += gridDim.x * 8) {
        const int b = row / SEQ;
        const float* hp = h + (size_t)row * DM;
        f32x4 v[4]; float ss = 0.f;
#pragma unroll
        for (int i = 0; i < 4; ++i) { v[i] = *(const f32x4*)(hp + i * 256 + lane * 4); ss += v[i][0] * v[i][0] + v[i][1] * v[i][1] + v[i][2] * v[i][2] + v[i][3] * v[i][3]; }
        ss = wave_sum(ss);
        if (lane == 0) ssq[row] = ss;
#pragma unroll
        for (int i = 0; i < 4; ++i) {
            const int col = i * 256 + lane * 4;
            const f32x4 gv = *(const f32x4*)(g + col), sv = *(const f32x4*)(sc + (size_t)b * (NADA * DM) + col);
            const f32x4 o = v[i] * gv * (sv + 1.0f);
            u32x2 w; w.x = cvt_pk_bf16(o[0], o[1]); w.y = cvt_pk_bf16(o[2], o[3]);
            *(u32x2*)(y + (size_t)row * DM + col) = w;
            u32x2 wx; wx.x = cvt_pk_bf16(v[i][0], v[i][1]); wx.y = cvt_pk_bf16(v[i][2], v[i][3]);
            *(u32x2*)(hb + (size_t)row * DM + col) = wx;
        }
    }
}
DI void bias_phase(unsigned char* ws, int tid) {
    tid = launder_v(tid);
    const int wave = tid >> 6, lane = tid & 63;
    const float* mod = (const float*)(ws + WS_MOD);
    for (int ri = blockIdx.x * 8 + wave; ri < 4 * 2 * FF + 2 * INW; ri += gridDim.x * 8) {
        const bf16_t* bt; const float* sh; float* outp; int bstride;
        if (ri < 4 * 2 * FF) { const int lf = ri / (2 * FF), n = ri % (2 * FF), l = lf >> 1, sb = (lf & 1) * 2;
            bt = (const bf16_t*)(ws + WS_UP + (size_t)lf * SZ_UP) + (size_t)n * DM; sh = mod + (size_t)l * 8 * (NADA * DM) + (3 * sb) * DM;
            outp = (float*)(ws + WS_BUP) + (size_t)lf * 8 * (2 * FF) + n; bstride = 2 * FF;
        } else { const int r2 = ri - 4 * 2 * FF, l = r2 / INW, n = r2 % INW;
            bt = (const bf16_t*)(ws + WS_IN + (size_t)l * SZ_IN) + (size_t)n * DM; sh = mod + (size_t)l * 8 * (NADA * DM) + 3 * DM;
            outp = (float*)(ws + WS_BIN) + (size_t)l * 8 * INW + n; bstride = INW; }
        float w[16];
#pragma unroll
        for (int i = 0; i < 2; ++i) { const u32x4 q = *(const u32x4*)(bt + lane * 16 + 8 * i);
#pragma unroll
            for (int k = 0; k < 4; ++k) { w[8 * i + 2 * k] = __uint_as_float(q[k] << 16); w[8 * i + 2 * k + 1] = __uint_as_float(q[k] & 0xffff0000u); } }
        float res = 0.f;
#pragma unroll
        for (int b = 0; b < 8; ++b) {
            float d = 0.f;
#pragma unroll
            for (int i = 0; i < 4; ++i) { const f32x4 sv = *(const f32x4*)(sh + (size_t)b * (NADA * DM) + lane * 16 + 4 * i); d += sv[0] * w[4 * i] + sv[1] * w[4 * i + 1] + sv[2] * w[4 * i + 2] + sv[3] * w[4 * i + 3]; }
            d = wave_sum(d);
            res = (lane == b) ? d : res;
        }
        if (lane < 8) outp[(size_t)lane * bstride] = res;
    }
}
DI void final_norm_phase(const bf16_t* h, float* out, const float* g, const float* ssq, int tid) {
    tid = launder_v(tid);
    const int wave = tid >> 6, lane = tid & 63;
    for (int row = blockIdx.x * 8 + wave; row < MTOK; row += gridDim.x * 8) {
        const float rstd = rsqrtf(ssq[row] * (1.0f / DM) + EPS);
#pragma unroll
        for (int i = 0; i < 2; ++i) {
            const int col = i * 512 + lane * 8;
            const u32x4 q = *(const u32x4*)(h + (size_t)row * DM + col);
            const f32x4 g0 = *(const f32x4*)(g + col), g1 = *(const f32x4*)(g + col + 4);
            const f32x4 h0 = {__uint_as_float(q.x << 16), __uint_as_float(q.x & 0xffff0000u), __uint_as_float(q.y << 16), __uint_as_float(q.y & 0xffff0000u)};
            const f32x4 h1 = {__uint_as_float(q.z << 16), __uint_as_float(q.z & 0xffff0000u), __uint_as_float(q.w << 16), __uint_as_float(q.w & 0xffff0000u)};
            *(f32x4*)(out + (size_t)row * DM + col) = h0 * rstd * g0; *(f32x4*)(out + (size_t)row * DM + col + 4) = h1 * rstd * g1;
        }
    }
}

#define MFMA32(a, b, c) __builtin_amdgcn_mfma_f32_32x32x16_bf16((a), (b), (c), 0, 0, 0)
DI bf16x8 pack8(const f32x16& x, int s) {
    u32x4 p; p.x = cvt_pk_bf16(x[8 * s], x[8 * s + 1]); p.y = cvt_pk_bf16(x[8 * s + 2], x[8 * s + 3]); p.z = cvt_pk_bf16(x[8 * s + 4], x[8 * s + 5]); p.w = cvt_pk_bf16(x[8 * s + 6], x[8 * s + 7]);
    return __builtin_bit_cast(bf16x8, p);
}

DI void sgu_item(const Params& p, int l, int item, LAS unsigned char* lds, int tid) {
    tid = launder_v(tid); unsigned char* wsl = launder_p(p.ws);
    const bf16_t* P = (const bf16_t*)(wsl + WS_PG); bf16_t* mixed = (bf16_t*)(wsl + WS_MIX);
    const int b = item >> 7, rem = item & 127, chunk = rem >> 2, hh = rem & 3;
    const size_t T0 = (size_t)b * SEQ + chunk * 128;
    {
        const int j = tid >> 2, qd = tid & 3;
        const bf16_t* vp = P + (T0 + j) * INW + 512 + 128 * hh + 32 * qd;
        float v[32];
#pragma unroll
        for (int i = 0; i < 4; ++i) { const u32x4 w = *(const u32x4*)(vp + 8 * i);
#pragma unroll
            for (int k = 0; k < 4; ++k) { v[8 * i + 2 * k] = __uint_as_float(w[k] << 16); v[8 * i + 2 * k + 1] = __uint_as_float(w[k] & 0xffff0000u); } }
        float sum = 0.f;
#pragma unroll
        for (int i = 0; i < 32; ++i) sum += v[i];
        sum += __shfl_xor(sum, 1); sum += __shfl_xor(sum, 2);
        const float mu = sum * (1.0f / 128.0f);
        float sq = 0.f;
#pragma unroll
        for (int i = 0; i < 32; ++i) { const float d = v[i] - mu; sq += d * d; }
        sq += __shfl_xor(sq, 1); sq += __shfl_xor(sq, 2);
        const float rstd = rsqrtf(sq * (1.0f / 128.0f) + EPS);
        const float* lg = p.sgu_ln_g + ((size_t)l * 4 + hh) * 128 + 32 * qd; const float* lb = p.sgu_ln_b + ((size_t)l * 4 + hh) * 128 + 32 * qd;
#pragma unroll
        for (int i = 0; i < 32; ++i) { const float o = (v[i] - mu) * rstd * lg[i] + lb[i]; *(LAS bf16_t*)(lds + (32 * qd + i) * 272 + j * 2) = f2bf(o); }
    }
    __syncthreads();
    {
        const int wave = __builtin_amdgcn_readfirstlane(tid >> 6), lane = tid & 63, r = lane & 31, h = lane >> 5;
        const int c0 = 32 * (wave & 3);
        const bf16_t* Wsb = (const bf16_t*)(wsl + WS_SGUW) + ((size_t)l * 4 + hh) * 128 * 128;
#pragma unroll
        for (int q = 0; q < 2; ++q) {
            const int itile = (wave < 4) ? (q ? 3 : 0) : (q ? 2 : 1), i0 = 32 * itile;
            f32x16 acc;
#pragma unroll
            for (int i = 0; i < 16; ++i) acc[i] = 0.f;
            const bf16_t* wrow = Wsb + (size_t)(i0 + r) * 128 + 8 * h;
            const LAS unsigned char* arow = lds + (c0 + r) * 272 + 16 * h;
            for (int ks = 0; ks < 2 * (itile + 1); ++ks) {
                const bf16x8 af = *(const LAS bf16x8*)(arow + ks * 32);
                const bf16x8 bfr = *(const bf16x8*)(wrow + ks * 16);
                acc = MFMA32(af, bfr, acc);
            }
            const float bs = p.sgu_b[((size_t)l * 4 + hh) * 128 + i0 + r];
            const size_t tok = T0 + i0 + r;
#pragma unroll
            for (int g = 0; g < 4; ++g) {
                const int c = c0 + 8 * g + 4 * h;
                const u32x2 uw = *(const u32x2*)(P + tok * INW + 128 * hh + c);
                const float u0 = __uint_as_float(uw.x << 16), u1 = __uint_as_float(uw.x & 0xffff0000u), u2 = __uint_as_float(uw.y << 16), u3 = __uint_as_float(uw.y & 0xffff0000u);
                u32x2 w; w.x = cvt_pk_bf16(u0 * (acc[4 * g] + bs), u1 * (acc[4 * g + 1] + bs)); w.y = cvt_pk_bf16(u2 * (acc[4 * g + 2] + bs), u3 * (acc[4 * g + 3] + bs));
                *(u32x2*)(mixed + tok * DM + 128 * hh + c) = w;
            }
        }
    }
    __syncthreads();
}

constexpr int AT_OPITCH = 136, AT_LSE_OFF = 512 * AT_OPITCH, AT_V_OFF = AT_LSE_OFF + 2048, AT_VPITCH = 144, AT_VBYTES = 32 * AT_VPITCH;
DI void attn_item(const Params& p, int item, LAS unsigned char* lds, int tid) {
    tid = launder_v(tid); unsigned char* wsl = launder_p(p.ws);
    const bf16_t* P = (const bf16_t*)(wsl + WS_PG); bf16_t* mixed = (bf16_t*)(wsl + WS_MIX);
    const int wave = __builtin_amdgcn_readfirstlane(tid >> 6), lane = tid & 63, r = lane & 31, h = lane >> 5;
    const int xcd = item & 7, li = item >> 3, bh = (li >> 3) * 8 + xcd, sp = li & 7, b = bh >> 3, hd = bh & 7;
    const bf16_t* Pb = P + (size_t)b * SEQ * INW;
    LAS unsigned char* Ost = lds; LAS float* Lse = (LAS float*)(lds + AT_LSE_OFF); LAS unsigned char* Vst = lds + AT_V_OFF + wave * AT_VBYTES;
    const int vkey = lane >> 1, vhalf = lane & 1;
    const int trq = (lane >> 2) & 3, trp = lane & 3, dhalf = (lane >> 4) & 1;
    const LAS unsigned char* trbase = Vst + (4 * h + trq) * AT_VPITCH + 32 * dhalf + 8 * trp;
    for (int br = 0; br < 3; ++br) {
        const int ldil = 2 * br, dil = 1 << ldil;
        for (int tk = wave; tk < 16; tk += 8) {
            const int res = tk & (dil - 1), qtl = tk >> ldil;
            const int Pq0 = ((sp * 512) >> ldil) + 32 * qtl;
            bf16x8 qf[4];
            { const bf16_t* qp = Pb + (size_t)(res + dil * (Pq0 + r)) * INW + 1024 + 64 * hd + 32 * h;
#pragma unroll
              for (int s = 0; s < 4; ++s) qf[s] = *(const bf16x8*)(qp + 8 * s); }
            f32x16 o0, o1;
#pragma unroll
            for (int i = 0; i < 16; ++i) { o0[i] = 0.f; o1[i] = 0.f; }
            float m = -INFINITY, lsum = 0.f;
            const int kt0 = (Pq0 >= 128) ? -4 : -(Pq0 >> 5);
            bf16x8 kf[4]; u32x4 vr[4];
            { const int P0 = Pq0 + 32 * kt0;
              const bf16_t* kp = Pb + (size_t)(res + dil * (P0 + r)) * INW + 1536 + 64 * hd + 32 * h;
              const bf16_t* vp = Pb + (size_t)(res + dil * (P0 + vkey)) * INW + 2048 + 64 * hd + 32 * vhalf;
#pragma unroll
              for (int s = 0; s < 4; ++s) { kf[s] = *(const bf16x8*)(kp + 8 * s); vr[s] = *(const u32x4*)(vp + 8 * s); } }
            for (int kt = kt0; kt <= 0; ++kt) {
                bf16x8 kn[4]; u32x4 vn[4];
                { const int P0 = Pq0 + 32 * (kt < 0 ? kt + 1 : kt);
                  const bf16_t* kp = Pb + (size_t)(res + dil * (P0 + r)) * INW + 1536 + 64 * hd + 32 * h;
                  const bf16_t* vp = Pb + (size_t)(res + dil * (P0 + vkey)) * INW + 2048 + 64 * hd + 32 * vhalf;
#pragma unroll
                  for (int s = 0; s < 4; ++s) { kn[s] = *(const bf16x8*)(kp + 8 * s); vn[s] = *(const u32x4*)(vp + 8 * s); } }
                f32x16 sc;
#pragma unroll
                for (int i = 0; i < 16; ++i) sc[i] = 0.f;
#pragma unroll
                for (int s = 0; s < 4; ++s) sc = MFMA32(kf[s], qf[s], sc);
                if (kt == -4) {
#pragma unroll
                    for (int i = 0; i < 16; ++i) { const int kk = 8 * (i >> 2) + 4 * h + (i & 3); if (kk < r) sc[i] = -INFINITY; }
                }
                if (kt == 0) {
#pragma unroll
                    for (int i = 0; i < 16; ++i) { const int kk = 8 * (i >> 2) + 4 * h + (i & 3); if (kk > r) sc[i] = -INFINITY; }
                }
                float tmax = sc[0];
#pragma unroll
                for (int i = 1; i < 16; ++i) tmax = fmaxf(tmax, sc[i]);
                tmax = fmaxf(tmax, __shfl_xor(tmax, 32));
                const float mnew = fmaxf(m, tmax), alpha = fast_exp2(m - mnew);
                m = mnew;
                float psum = 0.f;
#pragma unroll
                for (int i = 0; i < 16; ++i) { sc[i] = fast_exp2(sc[i] - mnew); psum += sc[i]; }
                lsum = lsum * alpha + psum;
#pragma unroll
                for (int i = 0; i < 16; ++i) { o0[i] *= alpha; o1[i] *= alpha; }
#pragma unroll
                for (int s = 0; s < 4; ++s) *(LAS u32x4*)(Vst + vkey * AT_VPITCH + 64 * vhalf + 16 * s) = vr[s];
                asm volatile("" ::: "memory");
                const bf16x8 pb0 = pack8(sc, 0), pb1 = pack8(sc, 1);
#pragma unroll
                for (int s2 = 0; s2 < 2; ++s2) {
#pragma unroll
                    for (int dt = 0; dt < 2; ++dt) {
                        const s16x4 lo = __builtin_amdgcn_ds_read_tr16_b64_v4i16((LAS s16x4*)(trbase + (16 * s2) * AT_VPITCH + 64 * dt));
                        const s16x4 hi = __builtin_amdgcn_ds_read_tr16_b64_v4i16((LAS s16x4*)(trbase + (16 * s2 + 8) * AT_VPITCH + 64 * dt));
                        const bf16x8 vf = __builtin_shufflevector(lo, hi, 0, 1, 2, 3, 4, 5, 6, 7);
                        if (dt == 0) o0 = MFMA32(vf, s2 ? pb1 : pb0, o0); else o1 = MFMA32(vf, s2 ? pb1 : pb0, o1);
                    }
                }
                asm volatile("" ::: "memory");
#pragma unroll
                for (int s = 0; s < 4; ++s) { kf[s] = kn[s]; vr[s] = vn[s]; }
            }
            const float ltot = lsum + __shfl_xor(lsum, 32);
            float lse = m + __builtin_amdgcn_logf(ltot);
            float fn = fast_rcp(ltot), fp = 0.f;
            const int tl = res + dil * (32 * qtl + r);
            LAS unsigned char* orow = Ost + tl * AT_OPITCH + 8 * h;
            if (br > 0) {
                const float lp = Lse[tl], mx = fmaxf(lp, lse), wp = fast_exp2(lp - mx), wn = fast_exp2(lse - mx), den = wp + wn, iden = fast_rcp(den);
                fp = wp * iden; fn = fn * wn * iden; lse = mx + __builtin_amdgcn_logf(den);
            }
            if (br < 2) { if (h == 0) Lse[tl] = lse; }
            bf16_t* grow = mixed + ((size_t)b * SEQ + sp * 512 + tl) * DM + 512 + 64 * hd + 4 * h;
#pragma unroll
            for (int dt = 0; dt < 2; ++dt)
#pragma unroll
                for (int g = 0; g < 4; ++g) {
                    float v0 = (dt ? o1 : o0)[4 * g] * fn, v1 = (dt ? o1 : o0)[4 * g + 1] * fn, v2 = (dt ? o1 : o0)[4 * g + 2] * fn, v3 = (dt ? o1 : o0)[4 * g + 3] * fn;
                    if (br > 0) { const u32x2 pw = *(const LAS u32x2*)(orow + 64 * dt + 16 * g);
                        v0 += fp * __uint_as_float(pw.x << 16); v1 += fp * __uint_as_float(pw.x & 0xffff0000u); v2 += fp * __uint_as_float(pw.y << 16); v3 += fp * __uint_as_float(pw.y & 0xffff0000u); }
                    u32x2 w; w.x = cvt_pk_bf16(v0, v1); w.y = cvt_pk_bf16(v2, v3);
                    if (br < 2) *(LAS u32x2*)(orow + 64 * dt + 16 * g) = w; else *(u32x2*)(grow + 32 * dt + 8 * g) = w;
                }
        }
        __syncthreads();
    }
}


#define XB_TMO      128
#define XB_XCNT(j)  (256  + 64 * (j))
#define XB_XSUB(j)  (1280 + 64 * (j))
#define XB_XGEN(j)  (2304 + 64 * (j))
#define XB_TOP      3328
#define XB_TOPGEN   3392
#define XCD_BAR_WORDS 3456
#define XB_SPIN_CAP (1u << 20)
DI unsigned xb_ld(unsigned* p)              { return __hip_atomic_load(p, __ATOMIC_RELAXED, __HIP_MEMORY_SCOPE_AGENT); }
DI unsigned xb_add(unsigned* p, unsigned v) { return __hip_atomic_fetch_add(p, v, __ATOMIC_RELAXED, __HIP_MEMORY_SCOPE_AGENT); }
DI unsigned xb_xcc_id() { return (unsigned)__builtin_amdgcn_s_getreg((3 << 11) | 20) & 0xFu; }
#define XB_SPIN(cond, bar) do { unsigned _sp = 0; while (cond) { __builtin_amdgcn_s_sleep(1); \
    if ((++_sp & 255u) == 0u) { if (xb_ld(&(bar)[XB_TMO])) break; if (_sp > XB_SPIN_CAP) { atomicAdd(&(bar)[XB_TMO], 1u); break; } } } } while (0)
struct XcdBarrier { unsigned* bar; unsigned x; volatile LAS unsigned* st; };
DI XcdBarrier xcd_barrier_post(unsigned* bar, volatile LAS unsigned* st) {
    XcdBarrier b; b.bar = bar; b.x = xb_xcc_id(); b.st = st;
    if (threadIdx.x == 0) (void)xb_add(&bar[XB_XCNT(b.x)], 1u);
    return b;
}
DI void xcd_barrier_complete(unsigned* bar, unsigned x, unsigned& nloc, unsigned& nx) {
    const unsigned G = gridDim.x * gridDim.y * gridDim.z;
    unsigned sum, cnt, mine, sp = 0u;
    for (;;) {
        sum = 0u; cnt = 0u; mine = 0u;
#pragma unroll
        for (unsigned j = 0; j < 16; ++j) { const unsigned c = xb_ld(&bar[XB_XCNT(j)]); sum += c; cnt += (c > 0u) ? 1u : 0u; mine = (j == x) ? c : mine; }
        if (sum == G) break;
        __builtin_amdgcn_s_sleep(1);
        if ((++sp & 255u) == 0u) { if (xb_ld(&bar[XB_TMO])) break; if (sp > XB_SPIN_CAP) { atomicAdd(&bar[XB_TMO], 1u); break; } }
    }
    nloc = mine > 0u ? mine : 1u; nx = cnt > 0u ? cnt : 1u;
}
DI void xcd_barrier(const XcdBarrier& b0) {
    asm volatile("s_waitcnt vmcnt(0)" ::: "memory");
    __syncthreads();
    if (threadIdx.x == 0) {
        XcdBarrier b; b.bar = launder_p(b0.bar); b.x = xb_xcc_id(); b.st = b0.st;
        unsigned* bar = b.bar;
        __builtin_amdgcn_s_waitcnt(0);
        unsigned nloc = b.st[0], nx = b.st[1];
        if (nloc == 0u) { xcd_barrier_complete(bar, b.x, nloc, nx); b.st[0] = nloc; b.st[1] = nx; }
        const unsigned old = xb_add(&bar[XB_XSUB(b.x)], 1u);
        const unsigned gen = old / nloc;
        if (old + 1u == (gen + 1u) * nloc) {
            __builtin_amdgcn_fence(__ATOMIC_RELEASE, "agent");
            asm volatile("s_waitcnt vmcnt(0)" ::: "memory");
            const unsigned og = xb_add(&bar[XB_TOP], 1u);
            const unsigned tg = og / nx;
            if (og + 1u == (tg + 1u) * nx) xb_add(&bar[XB_TOPGEN], 1u);
            else XB_SPIN(xb_ld(&bar[XB_TOPGEN]) == tg, bar);
            __builtin_amdgcn_fence(__ATOMIC_ACQUIRE, "agent");
            xb_add(&bar[XB_XGEN(b.x)], 1u);
            asm volatile("s_waitcnt vmcnt(0)" ::: "memory");
        } else {
            XB_SPIN(xb_ld(&bar[XB_XGEN(b.x)]) == gen, bar);
            __builtin_amdgcn_fence(__ATOMIC_ACQUIRE, "agent");
            asm volatile("s_waitcnt vmcnt(0)" ::: "memory");
        }
    }
    __syncthreads();
}

__global__ void __launch_bounds__(NTHR, 2) fwd_megakernel(Params p) {
    extern __shared__ __attribute__((aligned(16))) unsigned char smem[];
    LAS unsigned char* lds = (LAS unsigned char*)smem;
    cg::grid_group grid = cg::this_grid();
    const int tid = threadIdx.x;
    unsigned char* ws = p.ws;
    volatile LAS unsigned* bst = (volatile LAS unsigned*)(lds + 131072);
    if (tid < 4) bst[tid] = 0u;
    __syncthreads();
    const XcdBarrier xbar = xcd_barrier_post((unsigned*)(ws + WS_BAR), bst);

    prelude_phase(p, lds, tid);
    grid.sync();
    norm0_phase(p.x, p.norm_g, (const float*)(ws + WS_MOD) + DM, (bf16_t*)(ws + WS_Y), (float*)(ws + WS_SSQ), (bf16_t*)(ws + WS_H), tid);
    bias_phase(ws, tid);
    xcd_barrier(xbar);

    for (int l = 0; l < 2; ++l) {
        for (int sb = 0; sb < 3; ++sb) {
            ws = launder_p(ws);
            const float* mod = (const float*)(ws + WS_MOD);
            const float* modl = mod + (size_t)l * 8 * (NADA * DM);
            bf16_t* Y = (bf16_t*)(ws + WS_Y); bf16_t* PG = (bf16_t*)(ws + WS_PG);
            const int slot = l * 3 + sb;
            float* ssq = (float*)(ws + WS_SSQ);
            bf16_t* H = (bf16_t*)(ws + WS_H);
            const bf16_t* A2; const bf16_t* B2; int K2; float gsc;
            if (sb != 1) {
                const int lf = l * 2 + (sb >> 1);
                pg8::Gemm g{Y, (const bf16_t*)(ws + WS_UP + (size_t)lf * SZ_UP), MTOK, 2 * FF, DM};
                pg8::StaticOrder S; S.init(MTOK, 2 * FF, (int)gridDim.x, (int)blockIdx.x);
                EpiSwiglu E{PG, ssq + (size_t)slot * MTOK, (const float*)(ws + WS_BUP) + (size_t)lf * 8 * (2 * FF)};
                pg8::gemm_phase<EpiSwiglu>(lds, g, S, E);
                xcd_barrier(xbar);
                A2 = PG; B2 = (const bf16_t*)(ws + WS_DN + (size_t)lf * SZ_DN); K2 = FF; gsc = 0.5f;
            } else {
                pg8::Gemm g{Y, (const bf16_t*)(ws + WS_IN + (size_t)l * SZ_IN), MTOK, INW, DM};
                pg8::StaticOrder S; S.init(MTOK, INW, (int)gridDim.x, (int)blockIdx.x);
                EpiIn E{PG, (const float*)(ws + WS_ROPE), ssq + (size_t)slot * MTOK, (const float*)(ws + WS_BIN) + (size_t)l * 8 * INW};
                pg8::gemm_phase<EpiIn>(lds, g, S, E);
                xcd_barrier(xbar);
                for (int it = blockIdx.x; it < 1024; it += gridDim.x) sgu_item(p, l, it, lds, tid);
                for (int it = blockIdx.x; it < 512; it += gridDim.x) attn_item(p, it, lds, tid);
                xcd_barrier(xbar);
                A2 = (const bf16_t*)(ws + WS_MIX); B2 = (const bf16_t*)(ws + WS_OUT + (size_t)l * SZ_OUT); K2 = DM; gsc = 1.0f;
            }
            {
                const int ns = slot + 1, nl = ns / 3, nsb = ns % 3;
                pg8::Gemm g{A2, B2, MTOK, DM, K2};
                pg8::StaticOrder S; S.init(MTOK, DM, (int)gridDim.x, (int)blockIdx.x);
                EpiResid E{H, H, modl + (3 * sb + 2) * DM, (ns < 6) ? Y : (bf16_t*)nullptr, ssq + (size_t)ns * MTOK,
                           p.norm_g + (size_t)(ns < 6 ? ns : 0) * DM, mod + (size_t)(ns < 6 ? nl : 0) * 8 * (NADA * DM) + (3 * nsb + 1) * DM, gsc, 0.f};
                pg8::gemm_phase<EpiResid>(lds, g, S, E);
                xcd_barrier(xbar);
            }
        }
    }
    ws = launder_p(ws);
    final_norm_phase((const bf16_t*)(ws + WS_H), p.out, p.final_g, (const float*)(ws + WS_SSQ) + (size_t)6 * MTOK, tid);
}

constexpr int LDS_BYTES = 131072 + 16;
extern "C" void kernel_launch(void* const* d_in, const int* in_sizes, int n_in, void* d_out, int out_size, void* d_ws, size_t ws_size, hipStream_t stream) {
    static int grid_blocks = 0;
    if (!grid_blocks) {
        int dev = 0, cus = 0, per_cu = 0;
        hipGetDevice(&dev);
        hipDeviceGetAttribute(&cus, hipDeviceAttributeMultiprocessorCount, dev);
        hipFuncSetAttribute((const void*)fwd_megakernel, hipFuncAttributeMaxDynamicSharedMemorySize, LDS_BYTES);
        hipOccupancyMaxActiveBlocksPerMultiprocessor(&per_cu, (const void*)fwd_megakernel, NTHR, LDS_BYTES);
        if (per_cu < 1) per_cu = 1;
        grid_blocks = cus * per_cu;
        if (ws_size < WS_END) fprintf(stderr, "kernel_launch: workspace too small (%zu < %zu)\n", ws_size, (size_t)WS_END);
    }
    Params p{};
    p.x = (const float*)d_in[0]; p.c = (const float*)d_in[1]; p.ada_w = (const float*)d_in[2]; p.ada_b = (const float*)d_in[3]; p.norm_g = (const float*)d_in[4];
    p.f1g = (const float*)d_in[5]; p.f1u = (const float*)d_in[6]; p.f1d = (const float*)d_in[7]; p.f2g = (const float*)d_in[8]; p.f2u = (const float*)d_in[9]; p.f2d = (const float*)d_in[10];
    p.w_in = (const float*)d_in[11]; p.sgu_ln_g = (const float*)d_in[12]; p.sgu_ln_b = (const float*)d_in[13]; p.sgu_w = (const float*)d_in[14]; p.sgu_b = (const float*)d_in[15];
    p.w_out = (const float*)d_in[16]; p.final_g = (const float*)d_in[17];
    p.out = (float*)d_out; p.ws = (unsigned char*)d_ws;
    (void)hipMemsetAsync((unsigned char*)d_ws + WS_BAR, 0, ZERO_BYTES, stream);
    void* args[] = {&p};
    hipError_t e = hipLaunchCooperativeKernel((const void*)fwd_megakernel, dim3(grid_blocks), dim3(NTHR), args, LDS_BYTES, stream);
    if (e != hipSuccess) fprintf(stderr, "cooperative launch failed: %s (grid %d)\n", hipGetErrorString(e), grid_blocks);
}
```

```cpp
#include <hip/hip_runtime.h>
#include <hip/hip_cooperative_groups.h>
#include <cstdio>
namespace cg = cooperative_groups;

#define LAS __attribute__((address_space(3)))
#define DI __device__ __forceinline__
typedef unsigned short bf16_t;
typedef short bf16x8 __attribute__((ext_vector_type(8)));
typedef short s16x4 __attribute__((ext_vector_type(4)));
typedef float f32x4 __attribute__((ext_vector_type(4)));
typedef float f32x2 __attribute__((ext_vector_type(2)));
typedef float f32x16 __attribute__((ext_vector_type(16)));
typedef unsigned u32x4 __attribute__((ext_vector_type(4)));
typedef unsigned u32x2 __attribute__((ext_vector_type(2)));

constexpr int DM = 1024, NB = 8, SEQ = 4096, MTOK = NB * SEQ, FF = 2816, INW = 2560, NADA = 9;
constexpr int NTHR = 512;
constexpr float EPS = 1e-6f;

constexpr size_t SZ_UP = (size_t)2 * FF * DM * 2;
constexpr size_t SZ_DN = (size_t)DM * FF * 2;
constexpr size_t SZ_IN = (size_t)INW * DM * 2;
constexpr size_t SZ_OUT = (size_t)DM * DM * 2;
constexpr size_t WS_UP = 0;
constexpr size_t WS_DN = WS_UP + 4 * SZ_UP;
constexpr size_t WS_IN = WS_DN + 4 * SZ_DN;
constexpr size_t WS_OUT = WS_IN + 2 * SZ_IN;
constexpr size_t WS_SGUW = WS_OUT + 2 * SZ_OUT;
constexpr size_t WS_MOD = WS_SGUW + (size_t)2 * 4 * 128 * 128 * 2;
constexpr size_t WS_ROPE = WS_MOD + (size_t)2 * 8 * 9216 * 4;
constexpr size_t WS_Y = WS_ROPE + (size_t)4096 * 32 * 8;
constexpr size_t WS_PG = WS_Y + (size_t)MTOK * DM * 2;
constexpr size_t WS_MIX = WS_PG + (size_t)MTOK * FF * 2;
constexpr size_t WS_H = WS_MIX + (size_t)MTOK * DM * 2;
constexpr size_t WS_BUP = WS_H + (size_t)MTOK * DM * 2;
constexpr size_t WS_BIN = WS_BUP + (size_t)4 * 8 * 2 * FF * 4;
constexpr size_t WS_BAR = WS_BIN + (size_t)2 * 8 * INW * 4;
constexpr size_t WS_SSQ = WS_BAR + 16384;
constexpr size_t ZERO_BYTES = 16384 + (size_t)7 * MTOK * 4;
constexpr size_t WS_END = WS_BAR + ZERO_BYTES;

struct Params {
    const float *x, *c, *ada_w, *ada_b, *norm_g, *f1g, *f1u, *f1d, *f2g, *f2u, *f2d, *w_in, *sgu_ln_g, *sgu_ln_b, *sgu_w, *sgu_b, *w_out, *final_g;
    float* out; unsigned char* ws;
};

DI int launder_v(int x) { asm volatile("" : "+v"(x)); return x; }
template <class T> DI T* launder_p(T* q) { size_t z = 0; asm volatile("" : "+s"(z)); return (T*)((unsigned char*)q + z); }
DI float bf2f(unsigned short v) { return __uint_as_float((unsigned)v << 16); }
DI unsigned short f2bf(float f) { unsigned u = __float_as_uint(f); u += 0x7fffu + ((u >> 16) & 1u); return (unsigned short)(u >> 16); }
DI unsigned cvt_pk_bf16(float lo, float hi) { unsigned r; asm("v_cvt_pk_bf16_f32 %0, %1, %2" : "=v"(r) : "v"(lo), "v"(hi)); return r; }
DI float fast_exp2(float x) { return __builtin_amdgcn_exp2f(x); }
DI float fast_rcp(float x) { return __builtin_amdgcn_rcpf(x); }
DI float silu_f(float x) { return x * fast_rcp(1.0f + fast_exp2(-1.4426950409f * x)); }
DI float gelu_tanh_f(float x) { const float t = 0.7978845608f * (x + 0.044715f * x * x * x); return x * fast_rcp(1.0f + fast_exp2(-2.8853900818f * t)); }

namespace pg8 {
constexpr int BM = 256, BK = 64, HALF = 128, HTB = HALF * BK * 2, STAGE_BYTES = 8 * HTB, NXCD = 8, WGM = 8;
DI int lds_byte(int r, int c) { const int st = (r >> 4) * 2 + (c >> 5), rr = r & 15, cc = c & 31, ob = rr * 64 + cc * 2; return st * 1024 + (ob ^ (((ob >> 9) & 1) << 5)); }
DI void stage_rc(int b, int& R, int& C) { const int st = b / 1024, sb = b % 1024, swz = sb ^ (((sb >> 9) & 1) << 5); R = (st >> 1) * 16 + swz / 64; C = (st & 1) * 32 + (swz % 64) / 2; }
DI int perm32(int rho) { const int n = rho >> 4, i = rho & 15; return 8 * (i >> 2) + 4 * n + (i & 3); }
struct Unit { int pm, pn; };
struct Gemm { const bf16_t* A; const bf16_t* Bt; int M, N, K; };
struct StaticOrder {
    int nM, nN, nwg, G, c;
    DI void init(int M, int N, int G_, int c_) { nM = M / BM; nN = N / BM; nwg = nM * nN; G = G_; c = c_; }
    DI bool next(int i, Unit& u) const {
        const long L = (long)i * G + c; if (L >= nwg) return false;
        int wgid = (int)L; { const int q = nwg / NXCD, r = nwg % NXCD, xcd = wgid % NXCD, off = wgid / NXCD; wgid = (xcd < r ? xcd * (q + 1) : r * (q + 1) + (xcd - r) * q) + off; }
        const int nig = WGM * nN, gid = wgid / nig, fm = gid * WGM, gsz = (nM - fm) < WGM ? (nM - fm) : WGM;
        u.pm = fm + ((wgid % nig) % gsz); u.pn = (wgid % nig) / gsz; return true;
    }
};

template <class Epi>
DI void gemm_phase(LAS unsigned char* lds, const Gemm g, const StaticOrder& S, const Epi& E) {
    const int tid = launder_v(threadIdx.x), wid = __builtin_amdgcn_readfirstlane(tid >> 6), lane = tid & 63, wr = wid >> 2, wc = wid & 3, fr = lane & 15, fq = lane >> 4;
    const int K = g.K, nt = K / BK;
    unsigned voffA[2], voffB[2];
#pragma unroll
    for (int i = 0; i < 2; ++i) { int R, C; stage_rc(tid * 16 + i * 8192, R, C); const int Rb = Epi::PERM ? ((R & ~31) + perm32(R & 31)) : R;
        voffA[i] = (unsigned)(R * K + C) * 2u; voffB[i] = (unsigned)(Rb * K + C) * 2u; }
    const size_t kstep = (size_t)(BK * 2);
    const size_t hstep = (size_t)HALF * K * 2;
    const size_t tstep = 2 * hstep;
    const unsigned ldsw = (unsigned)wid * 1024u;
    const int aoff = lds_byte(wr * 64 + fr, fq * 8), boff = lds_byte(wc * 32 + fr, fq * 8);
#define PG8_SA(b, h) (((b) * 2 + (h)) * HTB)
#define PG8_SB(b, h) ((4 + (b) * 2 + (h)) * HTB)
#define PG8_STAGE(bufoff, gbase, voff) do { _Pragma("unroll") for (int _i = 0; _i < 2; ++_i) \
        __builtin_amdgcn_global_load_lds((const unsigned*)((const char*)(gbase) + (voff)[_i]), (LAS unsigned*)(lds + (bufoff) + ldsw + _i * 8192), 16, 0, 0); } while (0)
#define PG8_LDA(dst, b, h) do { _Pragma("unroll") for (int m = 0; m < 4; ++m) _Pragma("unroll") for (int k = 0; k < 2; ++k) dst[m][k] = *(const LAS bf16x8*)(lds + PG8_SA(b, h) + aoff + m * 2048 + k * 1024); } while (0)
#define PG8_LDB(dst, b, h) do { _Pragma("unroll") for (int n = 0; n < 2; ++n) _Pragma("unroll") for (int k = 0; k < 2; ++k) dst[n][k] = *(const LAS bf16x8*)(lds + PG8_SB(b, h) + boff + n * 2048 + k * 1024); } while (0)
#define PG8_MMA(ai, bj, At, Bt) do { __builtin_amdgcn_s_setprio(1); _Pragma("unroll") for (int m = 0; m < 4; ++m) _Pragma("unroll") for (int n = 0; n < 2; ++n) _Pragma("unroll") for (int k = 0; k < 2; ++k) \
        acc[ai][bj][m][n] = __builtin_amdgcn_mfma_f32_16x16x32_bf16(Bt[n][k], At[m][k], acc[ai][bj][m][n], 0, 0, 0); __builtin_amdgcn_s_setprio(0); } while (0)
#define PG8_WAIT_V(n) asm volatile("s_waitcnt vmcnt(" #n ")" ::: "memory")
#define PG8_WAIT_L(n) asm volatile("s_waitcnt lgkmcnt(" #n ")" ::: "memory")
#define PG8_BAR __builtin_amdgcn_s_barrier()
#define PG8_SCHED __builtin_amdgcn_sched_barrier(0)
    Unit cur, nxt; int ui = 0;
    if (!S.next(0, cur)) return;
    f32x4 acc[2][2][4][2];
#pragma unroll
    for (int a = 0; a < 2; ++a)
#pragma unroll
        for (int b = 0; b < 2; ++b)
#pragma unroll
            for (int m = 0; m < 4; ++m)
#pragma unroll
                for (int n = 0; n < 2; ++n) acc[a][b][m][n] = (f32x4){0.f, 0.f, 0.f, 0.f};
    bf16x8 At[4][2], B0[2][2], B1[2][2];
    const char* cA = (const char*)g.A + (size_t)cur.pm * tstep; const char* cB = (const char*)g.Bt + (size_t)cur.pn * tstep;
    PG8_STAGE(PG8_SB(0, 0), cB, voffB); PG8_STAGE(PG8_SA(0, 0), cA, voffA); PG8_STAGE(PG8_SB(0, 1), cB + hstep, voffB); PG8_STAGE(PG8_SA(0, 1), cA + hstep, voffA);
    if (wr == 1) PG8_BAR;
    PG8_WAIT_V(4); PG8_BAR;
    PG8_STAGE(PG8_SB(1, 0), cB + kstep, voffB); PG8_STAGE(PG8_SA(1, 0), cA + kstep, voffA); PG8_STAGE(PG8_SB(1, 1), cB + hstep + kstep, voffB);
    PG8_WAIT_V(6); PG8_BAR;
    for (;;) {
        const bool has_next = S.next(ui + 1, nxt);
        const char* nA = has_next ? (const char*)g.A + (size_t)nxt.pm * tstep : cA; const char* nB = has_next ? (const char*)g.Bt + (size_t)nxt.pn * tstep : cB;
        for (int t = 0; t < nt; t += 2) {
            const bool last = (t == nt - 2);
            const char* a1 = cA + (size_t)(t + 1) * kstep;
            const char* a2 = last ? nA : cA + (size_t)(t + 2) * kstep; const char* b2 = last ? nB : cB + (size_t)(t + 2) * kstep;
            const char* a3 = a2 + kstep; const char* b3 = b2 + kstep;
            PG8_LDB(B0, 0, 0); PG8_SCHED; PG8_LDA(At, 0, 0); PG8_STAGE(PG8_SA(1, 1), a1 + hstep, voffA);
            PG8_WAIT_L(8); PG8_BAR; PG8_WAIT_L(0); PG8_MMA(0, 0, At, B0); PG8_BAR; PG8_SCHED;
            PG8_LDB(B1, 0, 1); PG8_STAGE(PG8_SB(0, 0), b2, voffB);
            PG8_BAR; PG8_WAIT_L(0); PG8_MMA(0, 1, At, B1); PG8_BAR;
            PG8_LDA(At, 0, 1); PG8_STAGE(PG8_SA(0, 0), a2, voffA);
            PG8_BAR; PG8_WAIT_L(0); PG8_MMA(1, 0, At, B0); PG8_BAR; PG8_SCHED;
            PG8_STAGE(PG8_SB(0, 1), b2 + hstep, voffB);
            PG8_WAIT_V(6); PG8_BAR; PG8_MMA(1, 1, At, B1); PG8_BAR;
            PG8_LDB(B0, 1, 0); PG8_SCHED; PG8_LDA(At, 1, 0); PG8_STAGE(PG8_SA(0, 1), a2 + hstep, voffA);
            PG8_WAIT_L(8); PG8_BAR; PG8_WAIT_L(0); PG8_MMA(0, 0, At, B0); PG8_BAR; PG8_SCHED;
            PG8_LDB(B1, 1, 1); PG8_STAGE(PG8_SB(1, 0), b3, voffB);
            PG8_BAR; PG8_WAIT_L(0); PG8_MMA(0, 1, At, B1); PG8_BAR;
            PG8_LDA(At, 1, 1); PG8_STAGE(PG8_SA(1, 0), a3, voffA);
            PG8_BAR; PG8_WAIT_L(0); PG8_MMA(1, 0, At, B0); PG8_BAR; PG8_SCHED;
            PG8_STAGE(PG8_SB(1, 1), b3 + hstep, voffB);
            PG8_WAIT_V(6); PG8_BAR; PG8_MMA(1, 1, At, B1); PG8_BAR;
        }
        E(acc, cur, wr, wc, fr, fq);
        if (!has_next) break;
#pragma unroll
        for (int a = 0; a < 2; ++a)
#pragma unroll
            for (int b = 0; b < 2; ++b)
#pragma unroll
                for (int m = 0; m < 4; ++m)
#pragma unroll
                    for (int n = 0; n < 2; ++n) acc[a][b][m][n] = (f32x4){0.f, 0.f, 0.f, 0.f};
        cur = nxt; cA = nA; cB = nB; ++ui;
    }
    PG8_WAIT_V(0);
    if (wr == 0) PG8_BAR;
    PG8_BAR;
#undef PG8_SA
#undef PG8_SB
#undef PG8_STAGE
#undef PG8_LDA
#undef PG8_LDB
#undef PG8_MMA
#undef PG8_WAIT_V
#undef PG8_WAIT_L
#undef PG8_BAR
#undef PG8_SCHED
}
}

struct EpiSwiglu {
    static constexpr bool PERM = true;
    bf16_t* G; const float* ssq; const float* bias;
    DI void operator()(const f32x4 (&acc)[2][2][4][2], const pg8::Unit& u, int wr, int wc, int fr, int fq) const {
        const int row0 = u.pm * 256 + wr * 64 + fr, col0 = u.pn * 128 + wc * 32 + 8 * fq, b = (u.pm * 256) / SEQ;
        const float* bp = bias + (size_t)b * (2 * FF) + u.pn * 256 + wc * 32 + 8 * fq;
        const f32x4 bg0 = *(const f32x4*)bp, bg1 = *(const f32x4*)(bp + 4), bu0 = *(const f32x4*)(bp + 128), bu1 = *(const f32x4*)(bp + 132);
        float sq[8];
#pragma unroll
        for (int i = 0; i < 8; ++i) sq[i] = ssq[row0 + (i >> 2) * 128 + (i & 3) * 16];
#pragma unroll
        for (int ai = 0; ai < 2; ++ai)
#pragma unroll
            for (int m = 0; m < 4; ++m) {
                bf16_t* rowp = G + (size_t)(row0 + ai * 128 + m * 16) * FF + col0;
                const float rstd = rsqrtf(sq[ai * 4 + m] * (1.0f / DM) + EPS);
                const f32x4 g0 = acc[ai][0][m][0] * rstd + bg0, g1 = acc[ai][0][m][1] * rstd + bg1, u0 = acc[ai][1][m][0] * rstd + bu0, u1 = acc[ai][1][m][1] * rstd + bu1;
                u32x4 w;
                w.x = cvt_pk_bf16(silu_f(g0[0]) * u0[0], silu_f(g0[1]) * u0[1]); w.y = cvt_pk_bf16(silu_f(g0[2]) * u0[2], silu_f(g0[3]) * u0[3]);
                w.z = cvt_pk_bf16(silu_f(g1[0]) * u1[0], silu_f(g1[1]) * u1[1]); w.w = cvt_pk_bf16(silu_f(g1[2]) * u1[2], silu_f(g1[3]) * u1[3]);
                *(u32x4*)rowp = w;
            }
    }
};
struct EpiResid {
    static constexpr bool PERM = true;
    const bf16_t* hin; bf16_t* hout; const float* gate;
    bf16_t* ynext; float* ssqn; const float* gnext; const float* scnext;
    float gscale, pad_;
    DI void operator()(const f32x4 (&acc)[2][2][4][2], const pg8::Unit& u, int wr, int wc, int fr, int fq) const {
        const int row0 = u.pm * 256 + wr * 64 + fr, col0 = u.pn * 256 + wc * 32 + 8 * fq, b = (u.pm * 256) / SEQ;
        const bool has_y = ynext != nullptr;
        float rs[8];
#pragma unroll
        for (int it = 0; it < 8; ++it) rs[it] = 0.f;
#pragma unroll
        for (int bj = 0; bj < 2; ++bj) {
            u32x4 hb[8];
#pragma unroll
            for (int it = 0; it < 8; ++it) hb[it] = *(const u32x4*)(hin + (size_t)(row0 + (it >> 2) * 128 + (it & 3) * 16) * DM + col0 + bj * 128);
            const float* gp = gate + (size_t)b * (NADA * DM) + col0 + bj * 128;
            const f32x4 gv0 = *(const f32x4*)gp * gscale, gv1 = *(const f32x4*)(gp + 4) * gscale;
            const float* np = gnext + col0 + bj * 128; const float* sp = scnext + (size_t)b * (NADA * DM) + col0 + bj * 128;
            const f32x4 gm0 = *(const f32x4*)np * (*(const f32x4*)sp + 1.0f), gm1 = *(const f32x4*)(np + 4) * (*(const f32x4*)(sp + 4) + 1.0f);
            __builtin_amdgcn_sched_barrier(0);
#pragma unroll
            for (int it = 0; it < 8; ++it) {
                const int ai = it >> 2, m = it & 3;
                const size_t off = (size_t)(row0 + ai * 128 + m * 16) * DM + col0 + bj * 128;
                const u32x4 q = hb[it];
                f32x4 h0 = {__uint_as_float(q.x << 16), __uint_as_float(q.x & 0xffff0000u), __uint_as_float(q.y << 16), __uint_as_float(q.y & 0xffff0000u)};
                f32x4 h1 = {__uint_as_float(q.z << 16), __uint_as_float(q.z & 0xffff0000u), __uint_as_float(q.w << 16), __uint_as_float(q.w & 0xffff0000u)};
                h0 += gv0 * acc[ai][bj][m][0]; h1 += gv1 * acc[ai][bj][m][1];
                rs[it] += h0[0] * h0[0] + h0[1] * h0[1] + h0[2] * h0[2] + h0[3] * h0[3] + h1[0] * h1[0] + h1[1] * h1[1] + h1[2] * h1[2] + h1[3] * h1[3];
                u32x4 wh; wh.x = cvt_pk_bf16(h0[0], h0[1]); wh.y = cvt_pk_bf16(h0[2], h0[3]); wh.z = cvt_pk_bf16(h1[0], h1[1]); wh.w = cvt_pk_bf16(h1[2], h1[3]);
                *(u32x4*)(hout + off) = wh;
                if (has_y) { const f32x4 a0 = h0 * gm0, a1 = h1 * gm1;
                    u32x4 wy; wy.x = cvt_pk_bf16(a0[0], a0[1]); wy.y = cvt_pk_bf16(a0[2], a0[3]); wy.z = cvt_pk_bf16(a1[0], a1[1]); wy.w = cvt_pk_bf16(a1[2], a1[3]);
                    *(u32x4*)(ynext + off) = wy; }
            }
            __builtin_amdgcn_sched_barrier(0);
        }
#pragma unroll
        for (int it = 0; it < 8; ++it) {
            float v = rs[it]; v += __shfl_xor(v, 16); v += __shfl_xor(v, 32);
            if (fq == 0) (void)__hip_atomic_fetch_add(ssqn + row0 + (it >> 2) * 128 + (it & 3) * 16, v, __ATOMIC_RELAXED, __HIP_MEMORY_SCOPE_AGENT);
        }
    }
};
struct EpiIn {
    static constexpr bool PERM = true;
    bf16_t* P; const float* rope; const float* ssq; const float* bias;
    DI void operator()(const f32x4 (&acc)[2][2][4][2], const pg8::Unit& u, int wr, int wc, int fr, int fq) const {
        const int row0 = u.pm * 256 + wr * 64 + fr, col0 = u.pn * 256 + wc * 32 + 8 * fq, kind = u.pn >> 1, b = (u.pm * 256) / SEQ;
        const int i0 = 16 * (wc & 1) + 4 * fq;
        const bool is_rope = (kind == 2 || kind == 3);
        const float* bp = bias + (size_t)b * INW + col0;
        const f32x4 bv00 = *(const f32x4*)bp, bv01 = *(const f32x4*)(bp + 4), bv10 = *(const f32x4*)(bp + 128), bv11 = *(const f32x4*)(bp + 132);
        float sq[8];
#pragma unroll
        for (int i = 0; i < 8; ++i) sq[i] = ssq[row0 + (i >> 2) * 128 + (i & 3) * 16];
        const float qs = (kind == 2) ? 0.125f * 1.4426950409f : 1.0f;
        f32x4 cs0 = {1.f, 0.f, 1.f, 0.f}, cs1 = {1.f, 0.f, 1.f, 0.f};
        if (is_rope) { const f32x4* rp = (const f32x4*)(rope + ((size_t)(row0 & (SEQ - 1)) * 32 + i0) * 2); cs0 = rp[0]; cs1 = rp[1]; }
#pragma unroll
        for (int it = 0; it < 8; ++it) {
            const int ai = it >> 2, m = it & 3;
            const int row = row0 + ai * 128 + m * 16;
            bf16_t* rowp = P + (size_t)row * INW + col0;
            const float rstd = rsqrtf(sq[it] * (1.0f / DM) + EPS);
            f32x4 cn0 = cs0, cn1 = cs1;
            if (is_rope && it < 7) { const int row2 = row0 + ((it + 1) >> 2) * 128 + ((it + 1) & 3) * 16;
                const f32x4* rp = (const f32x4*)(rope + ((size_t)(row2 & (SEQ - 1)) * 32 + i0) * 2); cn0 = rp[0]; cn1 = rp[1]; }
            __builtin_amdgcn_sched_barrier(0);
#pragma unroll
            for (int bj = 0; bj < 2; ++bj) {
                f32x4 v0 = acc[ai][bj][m][0] * rstd + (bj ? bv10 : bv00), v1 = acc[ai][bj][m][1] * rstd + (bj ? bv11 : bv01);
                if (kind <= 1) {
#pragma unroll
                    for (int j = 0; j < 4; ++j) { v0[j] = gelu_tanh_f(v0[j]); v1[j] = gelu_tanh_f(v1[j]); }
                } else if (kind <= 3) {
#pragma unroll
                    for (int j = 0; j < 4; ++j) { const float cj = (j < 2 ? cs0 : cs1)[(j & 1) * 2], sj = (j < 2 ? cs0 : cs1)[(j & 1) * 2 + 1];
                        const float x1 = v0[j], x2 = v1[j]; v0[j] = (x1 * cj - x2 * sj) * qs; v1[j] = (x2 * cj + x1 * sj) * qs; }
                }
                u32x4 w; w.x = cvt_pk_bf16(v0[0], v0[1]); w.y = cvt_pk_bf16(v0[2], v0[3]); w.z = cvt_pk_bf16(v1[0], v1[1]); w.w = cvt_pk_bf16(v1[2], v1[3]);
                *(u32x4*)(rowp + bj * 128) = w;
            }
            cs0 = cn0; cs1 = cn1;
        }
    }
};

DI void tr_tile(const float* src, int ld_src, int srccol0, int k0, bf16_t* dst, int ld_dst, int n0, bool rperm, LAS float* tile, int tid) {
#pragma unroll
    for (int i = 0; i < 2; ++i) {
        const int idx = tid + i * NTHR, row = idx >> 4, c4 = idx & 15;
        const f32x4 v = *(const f32x4*)(src + (size_t)(k0 + row) * ld_src + srccol0 + c4 * 4);
        LAS float* t = tile + row * 65 + c4 * 4; t[0] = v[0]; t[1] = v[1]; t[2] = v[2]; t[3] = v[3];
    }
    __syncthreads();
    const int p = tid >> 3, kc = (tid & 7) * 8;
    const int pp = rperm ? (4 * (p >> 3) + (p & 3) + 32 * ((p >> 2) & 1)) : p;
    float v[8];
#pragma unroll
    for (int j = 0; j < 8; ++j) v[j] = tile[(kc + j) * 65 + pp];
    u32x4 w; w.x = cvt_pk_bf16(v[0], v[1]); w.y = cvt_pk_bf16(v[2], v[3]); w.z = cvt_pk_bf16(v[4], v[5]); w.w = cvt_pk_bf16(v[6], v[7]);
    *(u32x4*)(dst + (size_t)(n0 + p) * ld_dst + k0 + kc) = w;
    __syncthreads();
}

constexpr int IT_MOD = 288;
constexpr int IT_ROPE = 256, IT_SGUW = 256;
constexpr int T_UP = 88 * 16, T_DN = 16 * 44, T_IN = 40 * 16, T_OUT = 16 * 16;
constexpr int IT_UP0 = IT_MOD + IT_ROPE + IT_SGUW, IT_DN0 = IT_UP0 + 4 * T_UP, IT_IN0 = IT_DN0 + 4 * T_DN, IT_OUT0 = IT_IN0 + 2 * T_IN, IT_END = IT_OUT0 + 2 * T_OUT;

DI void prelude_phase(const Params& p, LAS unsigned char* lds, int tid) {
    unsigned char* ws = p.ws;
    for (int it = blockIdx.x; it < IT_END; it += gridDim.x) {
        if (it < IT_MOD) {
            const int l = it / 144, cb = it % 144;
            LAS float* s = (LAS float*)lds; LAS float* red = (LAS float*)(lds + 32768);
            for (int i = tid; i < NB * DM; i += NTHR) s[i] = silu_f(p.c[i]);
            __syncthreads();
            const int cp = tid & 31, kg = tid >> 5;
            float a[8][2];
#pragma unroll
            for (int b = 0; b < 8; ++b) { a[b][0] = 0.f; a[b][1] = 0.f; }
            const float* w = p.ada_w + (size_t)l * DM * (NADA * DM) + (size_t)(kg * 64) * (NADA * DM) + cb * 64 + cp * 2;
#pragma unroll 4
            for (int k = 0; k < 64; ++k) {
                const f32x2 wv = *(const f32x2*)(w + (size_t)k * (NADA * DM));
#pragma unroll
                for (int b = 0; b < 8; ++b) { const float sv = s[b * DM + kg * 64 + k]; a[b][0] += sv * wv.x; a[b][1] += sv * wv.y; }
            }
#pragma unroll
            for (int b = 0; b < 8; ++b) { red[(kg * 8 + b) * 64 + cp * 2] = a[b][0]; red[(kg * 8 + b) * 64 + cp * 2 + 1] = a[b][1]; }
            __syncthreads();
            { const int b = tid >> 6, col = tid & 63; float sum = 0.f;
#pragma unroll
              for (int g = 0; g < 16; ++g) sum += red[(g * 8 + b) * 64 + col];
              const int n = cb * 64 + col;
              ((float*)(ws + WS_MOD))[((size_t)l * 8 + b) * (NADA * DM) + n] = sum + p.ada_b[(size_t)l * (NADA * DM) + n]; }
            __syncthreads();
        } else if (it < IT_MOD + IT_ROPE) {
            const int idx = (it - IT_MOD) * NTHR + tid, pos = idx >> 5, i = idx & 31;
            const float inv = exp2f(-(float)i * (13.287712379549449f / 32.0f));
            const float ang = (float)pos * inv;
            const double rev = (double)ang * 0.15915494309189535;
            const float fr = (float)(rev - floor(rev));
            f32x2 cs; cs.x = __builtin_amdgcn_cosf(fr); cs.y = __builtin_amdgcn_sinf(fr);
            ((f32x2*)(ws + WS_ROPE))[idx] = cs;
        } else if (it < IT_UP0) {
            const int idx = (it - IT_MOD - IT_ROPE) * NTHR + tid, j = idx & 127, i = (idx >> 7) & 127;
            ((bf16_t*)(ws + WS_SGUW))[idx] = (j <= i) ? f2bf(p.sgu_w[idx]) : (bf16_t)0;
        } else if (it < IT_DN0) {
            const int r = it - IT_UP0, lf = r / T_UP, t = r % T_UP, nb = t >> 4, kb = t & 15, l = lf >> 1, f = lf & 1;
            const int n0 = nb * 64, tl = n0 >> 8, half = (n0 >> 7) & 1, j0 = n0 & 127;
            const float* src = (f ? (half ? p.f2u : p.f2g) : (half ? p.f1u : p.f1g)) + (size_t)l * DM * FF;
            tr_tile(src, FF, tl * 128 + j0, kb * 64, (bf16_t*)(ws + WS_UP + (size_t)lf * SZ_UP), DM, n0, false, (LAS float*)lds, tid);
        } else if (it < IT_IN0) {
            const int r = it - IT_DN0, lf = r / T_DN, t = r % T_DN, nb = t / 44, kb = t % 44, l = lf >> 1, f = lf & 1;
            const float* src = (f ? p.f2d : p.f1d) + (size_t)l * FF * DM;
            tr_tile(src, DM, nb * 64, kb * 64, (bf16_t*)(ws + WS_DN + (size_t)lf * SZ_DN), FF, nb * 64, false, (LAS float*)lds, tid);
        } else if (it < IT_OUT0) {
            const int r = it - IT_IN0, l = r / T_IN, t = r % T_IN, nb = t >> 4, kb = t & 15, n0 = nb * 64;
            tr_tile(p.w_in + (size_t)l * DM * INW, INW, n0, kb * 64, (bf16_t*)(ws + WS_IN + (size_t)l * SZ_IN), DM, n0, (n0 >= 1024 && n0 < 2048), (LAS float*)lds, tid);
        } else {
            const int r = it - IT_OUT0, l = r / T_OUT, t = r % T_OUT, nb = t >> 4, kb = t & 15;
            tr_tile(p.w_out + (size_t)l * DM * DM, DM, nb * 64, kb * 64, (bf16_t*)(ws + WS_OUT + (size_t)l * SZ_OUT), DM, nb * 64, false, (LAS float*)lds, tid);
        }
    }
}

DI float wave_sum(float v) {
#pragma unroll
    for (int o = 32; o >= 1; o >>= 1) v += __shfl_xor(v, o);
    return v;
}
DI void norm0_phase(const float* h, const float* g, const float* sc, bf16_t* y, float* ssq, bf16_t* hb, int tid) {
    tid = launder_v(tid);
    const int wave = tid >> 6, lane = tid & 63;
    for (int row = blockIdx.x * 8 + wave; row < MTOK; row += gridDim.x * 8) {
        const int b = row / SEQ;
        const float* hp = h + (size_t)row * DM;
        f32x4 v[4]; float ss = 0.f;
#pragma unroll
        for (int i = 0; i < 4; ++i) { v[i] = *(const f32x4*)(hp + i * 256 + lane * 4); ss += v[i][0] * v[i][0] + v[i][1] * v[i][1] + v[i][2] * v[i][2] + v[i][3] * v[i][3]; }
        ss = wave_sum(ss);
        if (lane == 0) ssq[row] = ss;
#pragma unroll
        for (int i = 0; i < 4; ++i) {
            const int col = i * 256 + lane * 4;
            const f32x4 gv = *(const f32x4*)(g + col), sv = *(const f32x4*)(sc + (size_t)b * (NADA * DM) + col);
            const f32x4 o = v[i] * gv * (sv + 1.0f);
            u32x2 w; w.x = cvt_pk_bf16(o[0], o[1]); w.y = cvt_pk_bf16(o[2], o[3]);
            *(u32x2*)(y + (size_t)row * DM + col) = w;
            u32x2 wx; wx.x = cvt_pk_bf16(v[i][0], v[i][1]); wx.y = cvt_pk_bf16(v[i][2], v[i][3]);
            *(u32x2*)(hb + (size_t)row * DM + col) = wx;
        }
    }
}
DI void bias_phase(unsigned char* ws, int tid) {
    tid = launder_v(tid);
    const int wave = tid >> 6, lane = tid & 63;
    const float* mod = (const float*)(ws + WS_MOD);
    for (int ri = blockIdx.x * 8 + wave; ri < 4 * 2 * FF + 2 * INW; ri += gridDim.x * 8) {
        const bf16_t* bt; const float* sh; float* outp; int bstride;
        if (ri < 4 * 2 * FF) { const int lf = ri / (2 * FF), n = ri % (2 * FF), l = lf >> 1, sb = (lf & 1) * 2;
            bt = (const bf16_t*)(ws + WS_UP + (size_t)lf * SZ_UP) + (size_t)n * DM; sh = mod + (size_t)l * 8 * (NADA * DM) + (3 * sb) * DM;
            outp = (float*)(ws + WS_BUP) + (size_t)lf * 8 * (2 * FF) + n; bstride = 2 * FF;
        } else { const int r2 = ri - 4 * 2 * FF, l = r2 / INW, n = r2 % INW;
            bt = (const bf16_t*)(ws + WS_IN + (size_t)l * SZ_IN) + (size_t)n * DM; sh = mod + (size_t)l * 8 * (NADA * DM) + 3 * DM;
            outp = (float*)(ws + WS_BIN) + (size_t)l * 8 * INW + n; bstride = INW; }
        float w[16];
#pragma unroll
        for (int i = 0; i < 2; ++i) { const u32x4 q = *(const u32x4*)(bt + lane * 16 + 8 * i);
#pragma unroll
            for (int k = 0; k < 4; ++k) { w[8 * i + 2 * k] = __uint_as_float(q[k] << 16); w[8 * i + 2 * k + 1] = __uint_as_float(q[k] & 0xffff0000u); } }
        float res = 0.f;
#pragma unroll
        for (int b = 0; b < 8; ++b) {
            float d = 0.f;
#pragma unroll
            for (int i = 0; i < 4; ++i) { const f32x4 sv = *(const f32x4*)(sh + (size_t)b * (NADA * DM) + lane * 16 + 4 * i); d += sv[0] * w[4 * i] + sv[1] * w[4 * i + 1] + sv[2] * w[4 * i + 2] + sv[3] * w[4 * i + 3]; }
            d = wave_sum(d);
            res = (lane == b) ? d : res;
        }
        if (lane < 8) outp[(size_t)lane * bstride] = res;
    }
}
DI void final_norm_phase(const bf16_t* h, float* out, const float* g, const float* ssq, int tid) {
    tid = launder_v(tid);
    const int wave = tid >> 6, lane = tid & 63;
    for (int row = blockIdx.x * 8 + wave; row < MTOK; row += gridDim.x * 8) {
        const float rstd = rsqrtf(ssq[row] * (1.0f / DM) + EPS);
#pragma unroll
        for (int i = 0; i < 2; ++i) {
            const int col = i * 512 + lane * 8;
            const u32x4 q = *(const u32x4*)(h + (size_t)row * DM + col);
            const f32x4 g0 = *(const f32x4*)(g + col), g1 = *(const f32x4*)(g + col + 4);
            const f32x4 h0 = {__uint_as_float(q.x << 16), __uint_as_float(q.x & 0xffff0000u), __uint_as_float(q.y << 16), __uint_as_float(q.y & 0xffff0000u)};
            const f32x4 h1 = {__uint_as_float(q.z << 16), __uint_as_float(q.z & 0xffff0000u), __uint_as_float(q.w << 16), __uint_as_float(q.w & 0xffff0000u)};
            *(f32x4*)(out + (size_t)row * DM + col) = h0 * rstd * g0; *(f32x4*)(out + (size_t)row * DM + col + 4) = h1 * rstd * g1;
        }
    }
}

#define MFMA32(a, b, c) __builtin_amdgcn_mfma_f32_32x32x16_bf16((a), (b), (c), 0, 0, 0)
DI bf16x8 pack8(const f32x16& x, int s) {
    u32x4 p; p.x = cvt_pk_bf16(x[8 * s], x[8 * s + 1]); p.y = cvt_pk_bf16(x[8 * s + 2], x[8 * s + 3]); p.z = cvt_pk_bf16(x[8 * s + 4], x[8 * s + 5]); p.w = cvt_pk_bf16(x[8 * s + 6], x[8 * s + 7]);
    return __builtin_bit_cast(bf16x8, p);
}

DI void sgu_item(const Params& p, int l, int item, LAS unsigned char* lds, int tid) {
    tid = launder_v(tid); unsigned char* wsl = launder_p(p.ws);
    const bf16_t* P = (const bf16_t*)(wsl + WS_PG); bf16_t* mixed = (bf16_t*)(wsl + WS_MIX);
    const int b = item >> 7, rem = item & 127, chunk = rem >> 2, hh = rem & 3;
    const size_t T0 = (size_t)b * SEQ + chunk * 128;
    {
        const int j = tid >> 2, qd = tid & 3;
        const bf16_t* vp = P + (T0 + j) * INW + 512 + 128 * hh + 32 * qd;
        float v[32];
#pragma unroll
        for (int i = 0; i < 4; ++i) { const u32x4 w = *(const u32x4*)(vp + 8 * i);
#pragma unroll
            for (int k = 0; k < 4; ++k) { v[8 * i + 2 * k] = __uint_as_float(w[k] << 16); v[8 * i + 2 * k + 1] = __uint_as_float(w[k] & 0xffff0000u); } }
        float sum = 0.f;
#pragma unroll
        for (int i = 0; i < 32; ++i) sum += v[i];
        sum += __shfl_xor(sum, 1); sum += __shfl_xor(sum, 2);
        const float mu = sum * (1.0f / 128.0f);
        float sq = 0.f;
#pragma unroll
        for (int i = 0; i < 32; ++i) { const float d = v[i] - mu; sq += d * d; }
        sq += __shfl_xor(sq, 1); sq += __shfl_xor(sq, 2);
        const float rstd = rsqrtf(sq * (1.0f / 128.0f) + EPS);
        const float* lg = p.sgu_ln_g + ((size_t)l * 4 + hh) * 128 + 32 * qd; const float* lb = p.sgu_ln_b + ((size_t)l * 4 + hh) * 128 + 32 * qd;
#pragma unroll
        for (int i = 0; i < 32; ++i) { const float o = (v[i] - mu) * rstd * lg[i] + lb[i]; *(LAS bf16_t*)(lds + (32 * qd + i) * 272 + j * 2) = f2bf(o); }
    }
    __syncthreads();
    {
        const int wave = __builtin_amdgcn_readfirstlane(tid >> 6), lane = tid & 63, r = lane & 31, h = lane >> 5;
        const int c0 = 32 * (wave & 3);
        const bf16_t* Wsb = (const bf16_t*)(wsl + WS_SGUW) + ((size_t)l * 4 + hh) * 128 * 128;
#pragma unroll
        for (int q = 0; q < 2; ++q) {
            const int itile = (wave < 4) ? (q ? 3 : 0) : (q ? 2 : 1), i0 = 32 * itile;
            f32x16 acc;
#pragma unroll
            for (int i = 0; i < 16; ++i) acc[i] = 0.f;
            const bf16_t* wrow = Wsb + (size_t)(i0 + r) * 128 + 8 * h;
            const LAS unsigned char* arow = lds + (c0 + r) * 272 + 16 * h;
            const int nks = 2 * (itile + 1);
            bf16x8 wf[8];
#pragma unroll
            for (int ks = 0; ks < 8; ++ks) wf[ks] = *(const bf16x8*)(wrow + (ks < nks ? ks : 0) * 16);
            const float bs = p.sgu_b[((size_t)l * 4 + hh) * 128 + i0 + r];
            const size_t tok = T0 + i0 + r;
            u32x2 uwv[4];
#pragma unroll
            for (int g = 0; g < 4; ++g) uwv[g] = *(const u32x2*)(P + tok * INW + 128 * hh + c0 + 8 * g + 4 * h);
#pragma unroll
            for (int ks = 0; ks < 8; ++ks) if (ks < nks) {
                const bf16x8 af = *(const LAS bf16x8*)(arow + ks * 32);
                acc = MFMA32(af, wf[ks], acc);
            }
#pragma unroll
            for (int g = 0; g < 4; ++g) {
                const int c = c0 + 8 * g + 4 * h;
                const u32x2 uw = uwv[g];
                const float u0 = __uint_as_float(uw.x << 16), u1 = __uint_as_float(uw.x & 0xffff0000u), u2 = __uint_as_float(uw.y << 16), u3 = __uint_as_float(uw.y & 0xffff0000u);
                u32x2 w; w.x = cvt_pk_bf16(u0 * (acc[4 * g] + bs), u1 * (acc[4 * g + 1] + bs)); w.y = cvt_pk_bf16(u2 * (acc[4 * g + 2] + bs), u3 * (acc[4 * g + 3] + bs));
                *(u32x2*)(mixed + tok * DM + 128 * hh + c) = w;
            }
        }
    }
    __syncthreads();
}

constexpr int AT_OPITCH = 136, AT_LSE_OFF = 512 * AT_OPITCH, AT_V_OFF = AT_LSE_OFF + 2048, AT_VPITCH = 144, AT_VBYTES = 32 * AT_VPITCH;
DI void attn_item(const Params& p, int item, LAS unsigned char* lds, int tid) {
    tid = launder_v(tid); unsigned char* wsl = launder_p(p.ws);
    const bf16_t* P = (const bf16_t*)(wsl + WS_PG); bf16_t* mixed = (bf16_t*)(wsl + WS_MIX);
    const int wave = __builtin_amdgcn_readfirstlane(tid >> 6), lane = tid & 63, r = lane & 31, h = lane >> 5;
    const int xcd = item & 7, li = item >> 3, bh = (li >> 3) * 8 + xcd, sp = li & 7, b = bh >> 3, hd = bh & 7;
    const bf16_t* Pb = P + (size_t)b * SEQ * INW;
    LAS unsigned char* Ost = lds; LAS float* Lse = (LAS float*)(lds + AT_LSE_OFF); LAS unsigned char* Vst = lds + AT_V_OFF + wave * AT_VBYTES;
    const int vkey = lane >> 1, vhalf = lane & 1;
    const int trq = (lane >> 2) & 3, trp = lane & 3, dhalf = (lane >> 4) & 1;
    const LAS unsigned char* trbase = Vst + (4 * h + trq) * AT_VPITCH + 32 * dhalf + 8 * trp;
    for (int br = 0; br < 3; ++br) {
        const int ldil = 2 * br, dil = 1 << ldil;
        for (int tk = wave; tk < 16; tk += 8) {
            const int res = tk & (dil - 1), qtl = tk >> ldil;
            const int Pq0 = ((sp * 512) >> ldil) + 32 * qtl;
            bf16x8 qf[4];
            { const bf16_t* qp = Pb + (size_t)(res + dil * (Pq0 + r)) * INW + 1024 + 64 * hd + 32 * h;
#pragma unroll
              for (int s = 0; s < 4; ++s) qf[s] = *(const bf16x8*)(qp + 8 * s); }
            f32x16 o0, o1;
#pragma unroll
            for (int i = 0; i < 16; ++i) { o0[i] = 0.f; o1[i] = 0.f; }
            float m = -INFINITY, lsum = 0.f;
            const int jmin = (Pq0 >= 128) ? 0 : 4 - (Pq0 >> 5);
            bf16x8 kf[3][4]; u32x4 vr[3][4];
#define AT_LOAD(j, bi) do { const int _jj = ((j) < jmin) ? jmin : (j); const int _P0 = Pq0 + 32 * (_jj - 4); \
                const bf16_t* _kp = Pb + (size_t)(res + dil * (_P0 + r)) * INW + 1536 + 64 * hd + 32 * h; \
                const bf16_t* _vp = Pb + (size_t)(res + dil * (_P0 + vkey)) * INW + 2048 + 64 * hd + 32 * vhalf; \
                _Pragma("unroll") for (int _s = 0; _s < 4; ++_s) { kf[bi][_s] = *(const bf16x8*)(_kp + 8 * _s); vr[bi][_s] = *(const u32x4*)(_vp + 8 * _s); } } while (0)
            AT_LOAD(0, 0); AT_LOAD(1, 1); AT_LOAD(2, 2);
#pragma unroll
            for (int j = 0; j < 5; ++j) {
                const int bi = j % 3;
                if (j >= jmin) {
                    f32x16 sc;
#pragma unroll
                    for (int i = 0; i < 16; ++i) sc[i] = 0.f;
#pragma unroll
                    for (int s = 0; s < 4; ++s) sc = MFMA32(kf[bi][s], qf[s], sc);
                    if (j == 0) {
#pragma unroll
                        for (int i = 0; i < 16; ++i) { const int kk = 8 * (i >> 2) + 4 * h + (i & 3); if (kk < r) sc[i] = -INFINITY; }
                    }
                    if (j == 4) {
#pragma unroll
                        for (int i = 0; i < 16; ++i) { const int kk = 8 * (i >> 2) + 4 * h + (i & 3); if (kk > r) sc[i] = -INFINITY; }
                    }
                    float tmax = sc[0];
#pragma unroll
                    for (int i = 1; i < 16; ++i) tmax = fmaxf(tmax, sc[i]);
                    tmax = fmaxf(tmax, __shfl_xor(tmax, 32));
                    const float mnew = fmaxf(m, tmax), alpha = fast_exp2(m - mnew);
                    m = mnew;
                    float psum = 0.f;
#pragma unroll
                    for (int i = 0; i < 16; ++i) { sc[i] = fast_exp2(sc[i] - mnew); psum += sc[i]; }
                    lsum = lsum * alpha + psum;
#pragma unroll
                    for (int i = 0; i < 16; ++i) { o0[i] *= alpha; o1[i] *= alpha; }
#pragma unroll
                    for (int s = 0; s < 4; ++s) *(LAS u32x4*)(Vst + vkey * AT_VPITCH + 64 * vhalf + 16 * s) = vr[bi][s];
                    asm volatile("" ::: "memory");
                    const bf16x8 pb0 = pack8(sc, 0), pb1 = pack8(sc, 1);
#pragma unroll
                    for (int s2 = 0; s2 < 2; ++s2) {
#pragma unroll
                        for (int dt = 0; dt < 2; ++dt) {
                            const s16x4 lo = __builtin_amdgcn_ds_read_tr16_b64_v4i16((LAS s16x4*)(trbase + (16 * s2) * AT_VPITCH + 64 * dt));
                            const s16x4 hi = __builtin_amdgcn_ds_read_tr16_b64_v4i16((LAS s16x4*)(trbase + (16 * s2 + 8) * AT_VPITCH + 64 * dt));
                            const bf16x8 vf = __builtin_shufflevector(lo, hi, 0, 1, 2, 3, 4, 5, 6, 7);
                            if (dt == 0) o0 = MFMA32(vf, s2 ? pb1 : pb0, o0); else o1 = MFMA32(vf, s2 ? pb1 : pb0, o1);
                        }
                    }
                    asm volatile("" ::: "memory");
                }
                if (j + 3 < 5) AT_LOAD(j + 3, bi);
            }
#undef AT_LOAD
            const float ltot = lsum + __shfl_xor(lsum, 32);
            float lse = m + __builtin_amdgcn_logf(ltot);
            float fn = fast_rcp(ltot), fp = 0.f;
            const int tl = res + dil * (32 * qtl + r);
            LAS unsigned char* orow = Ost + tl * AT_OPITCH + 8 * h;
            if (br > 0) {
                const float lp = Lse[tl], mx = fmaxf(lp, lse), wp = fast_exp2(lp - mx), wn = fast_exp2(lse - mx), den = wp + wn, iden = fast_rcp(den);
                fp = wp * iden; fn = fn * wn * iden; lse = mx + __builtin_amdgcn_logf(den);
            }
            if (br < 2) { if (h == 0) Lse[tl] = lse; }
            bf16_t* grow = mixed + ((size_t)b * SEQ + sp * 512 + tl) * DM + 512 + 64 * hd + 4 * h;
#pragma unroll
            for (int dt = 0; dt < 2; ++dt)
#pragma unroll
                for (int g = 0; g < 4; ++g) {
                    float v0 = (dt ? o1 : o0)[4 * g] * fn, v1 = (dt ? o1 : o0)[4 * g + 1] * fn, v2 = (dt ? o1 : o0)[4 * g + 2] * fn, v3 = (dt ? o1 : o0)[4 * g + 3] * fn;
                    if (br > 0) { const u32x2 pw = *(const LAS u32x2*)(orow + 64 * dt + 16 * g);
                        v0 += fp * __uint_as_float(pw.x << 16); v1 += fp * __uint_as_float(pw.x & 0xffff0000u); v2 += fp * __uint_as_float(pw.y << 16); v3 += fp * __uint_as_float(pw.y & 0xffff0000u); }
                    u32x2 w; w.x = cvt_pk_bf16(v0, v1); w.y = cvt_pk_bf16(v2, v3);
                    if (br < 2) *(LAS u32x2*)(orow + 64 * dt + 16 * g) = w; else *(u32x2*)(grow + 32 * dt + 8 * g) = w;
                }
        }
        __syncthreads();
    }
}


#define XB_TMO      128
#define XB_XCNT(j)  (256  + 64 * (j))
#define XB_XSUB(j)  (1280 + 64 * (j))
#define XB_XGEN(j)  (2304 + 64 * (j))
#define XB_TOP      3328
#define XB_TOPGEN   3392
#define XCD_BAR_WORDS 3456
#define XB_SPIN_CAP (1u << 20)
DI unsigned xb_ld(unsigned* p)              { return __hip_atomic_load(p, __ATOMIC_RELAXED, __HIP_MEMORY_SCOPE_AGENT); }
DI unsigned xb_add(unsigned* p, unsigned v) { return __hip_atomic_fetch_add(p, v, __ATOMIC_RELAXED, __HIP_MEMORY_SCOPE_AGENT); }
DI unsigned xb_xcc_id() { return (unsigned)__builtin_amdgcn_s_getreg((3 << 11) | 20) & 0xFu; }
#define XB_SPIN(cond, bar) do { unsigned _sp = 0; while (cond) { __builtin_amdgcn_s_sleep(1); \
    if ((++_sp & 255u) == 0u) { if (xb_ld(&(bar)[XB_TMO])) break; if (_sp > XB_SPIN_CAP) { atomicAdd(&(bar)[XB_TMO], 1u); break; } } } } while (0)
struct XcdBarrier { unsigned* bar; unsigned x; volatile LAS unsigned* st; };
DI XcdBarrier xcd_barrier_post(unsigned* bar, volatile LAS unsigned* st) {
    XcdBarrier b; b.bar = bar; b.x = xb_xcc_id(); b.st = st;
    if (threadIdx.x == 0) (void)xb_add(&bar[XB_XCNT(b.x)], 1u);
    return b;
}
DI void xcd_barrier_complete(unsigned* bar, unsigned x, unsigned& nloc, unsigned& nx) {
    const unsigned G = gridDim.x * gridDim.y * gridDim.z;
    unsigned sum, cnt, mine, sp = 0u;
    for (;;) {
        sum = 0u; cnt = 0u; mine = 0u;
#pragma unroll
        for (unsigned j = 0; j < 16; ++j) { const unsigned c = xb_ld(&bar[XB_XCNT(j)]); sum += c; cnt += (c > 0u) ? 1u : 0u; mine = (j == x) ? c : mine; }
        if (sum == G) break;
        __builtin_amdgcn_s_sleep(1);
        if ((++sp & 255u) == 0u) { if (xb_ld(&bar[XB_TMO])) break; if (sp > XB_SPIN_CAP) { atomicAdd(&bar[XB_TMO], 1u); break; } }
    }
    nloc = mine > 0u ? mine : 1u; nx = cnt > 0u ? cnt : 1u;
}
DI void xcd_barrier(const XcdBarrier& b0) {
    asm volatile("s_waitcnt vmcnt(0)" ::: "memory");
    __syncthreads();
    if (threadIdx.x == 0) {
        XcdBarrier b; b.bar = launder_p(b0.bar); b.x = xb_xcc_id(); b.st = b0.st;
        unsigned* bar = b.bar;
        __builtin_amdgcn_s_waitcnt(0);
        unsigned nloc = b.st[0], nx = b.st[1];
        if (nloc == 0u) { xcd_barrier_complete(bar, b.x, nloc, nx); b.st[0] = nloc; b.st[1] = nx; }
        const unsigned old = xb_add(&bar[XB_XSUB(b.x)], 1u);
        const unsigned gen = old / nloc;
        if (old + 1u == (gen + 1u) * nloc) {
            __builtin_amdgcn_fence(__ATOMIC_RELEASE, "agent");
            asm volatile("s_waitcnt vmcnt(0)" ::: "memory");
            const unsigned og = xb_add(&bar[XB_TOP], 1u);
            const unsigned tg = og / nx;
            if (og + 1u == (tg + 1u) * nx) xb_add(&bar[XB_TOPGEN], 1u);
            else XB_SPIN(xb_ld(&bar[XB_TOPGEN]) == tg, bar);
            __builtin_amdgcn_fence(__ATOMIC_ACQUIRE, "agent");
            xb_add(&bar[XB_XGEN(b.x)], 1u);
            asm volatile("s_waitcnt vmcnt(0)" ::: "memory");
        } else {
            XB_SPIN(xb_ld(&bar[XB_XGEN(b.x)]) == gen, bar);
            __builtin_amdgcn_fence(__ATOMIC_ACQUIRE, "agent");
            asm volatile("s_waitcnt vmcnt(0)" ::: "memory");
        }
    }
    __syncthreads();
}

__global__ void __launch_bounds__(NTHR, 2) fwd_megakernel(Params p) {
    extern __shared__ __attribute__((aligned(16))) unsigned char smem[];
    LAS unsigned char* lds = (LAS unsigned char*)smem;
    cg::grid_group grid = cg::this_grid();
    const int tid = threadIdx.x;
    unsigned char* ws = p.ws;
    volatile LAS unsigned* bst = (volatile LAS unsigned*)(lds + 131072);
    if (tid < 4) bst[tid] = 0u;
    __syncthreads();
    const XcdBarrier xbar = xcd_barrier_post((unsigned*)(ws + WS_BAR), bst);

    prelude_phase(p, lds, tid);
    if (gridDim.x == 0x7fffffffu) grid.sync();
    xcd_barrier(xbar);
    norm0_phase(p.x, p.norm_g, (const float*)(ws + WS_MOD) + DM, (bf16_t*)(ws + WS_Y), (float*)(ws + WS_SSQ), (bf16_t*)(ws + WS_H), tid);
    bias_phase(ws, tid);
    xcd_barrier(xbar);

    for (int l = 0; l < 2; ++l) {
        for (int sb = 0; sb < 3; ++sb) {
            ws = launder_p(ws);
            const float* mod = (const float*)(ws + WS_MOD);
            const float* modl = mod + (size_t)l * 8 * (NADA * DM);
            bf16_t* Y = (bf16_t*)(ws + WS_Y); bf16_t* PG = (bf16_t*)(ws + WS_PG);
            const int slot = l * 3 + sb;
            float* ssq = (float*)(ws + WS_SSQ);
            bf16_t* H = (bf16_t*)(ws + WS_H);
            const bf16_t* A2; const bf16_t* B2; int K2; float gsc;
            if (sb != 1) {
                const int lf = l * 2 + (sb >> 1);
                pg8::Gemm g{Y, (const bf16_t*)(ws + WS_UP + (size_t)lf * SZ_UP), MTOK, 2 * FF, DM};
                pg8::StaticOrder S; S.init(MTOK, 2 * FF, (int)gridDim.x, (int)blockIdx.x);
                EpiSwiglu E{PG, ssq + (size_t)slot * MTOK, (const float*)(ws + WS_BUP) + (size_t)lf * 8 * (2 * FF)};
                pg8::gemm_phase<EpiSwiglu>(lds, g, S, E);
                xcd_barrier(xbar);
                A2 = PG; B2 = (const bf16_t*)(ws + WS_DN + (size_t)lf * SZ_DN); K2 = FF; gsc = 0.5f;
            } else {
                pg8::Gemm g{Y, (const bf16_t*)(ws + WS_IN + (size_t)l * SZ_IN), MTOK, INW, DM};
                pg8::StaticOrder S; S.init(MTOK, INW, (int)gridDim.x, (int)blockIdx.x);
                EpiIn E{PG, (const float*)(ws + WS_ROPE), ssq + (size_t)slot * MTOK, (const float*)(ws + WS_BIN) + (size_t)l * 8 * INW};
                pg8::gemm_phase<EpiIn>(lds, g, S, E);
                xcd_barrier(xbar);
                for (int it = blockIdx.x; it < 1024; it += gridDim.x) sgu_item(p, l, it, lds, tid);
                for (int it = blockIdx.x; it < 512; it += gridDim.x) attn_item(p, it, lds, tid);
                xcd_barrier(xbar);
                A2 = (const bf16_t*)(ws + WS_MIX); B2 = (const bf16_t*)(ws + WS_OUT + (size_t)l * SZ_OUT); K2 = DM; gsc = 1.0f;
            }
            {
                const int ns = slot + 1, nl = ns / 3, nsb = ns % 3;
                pg8::Gemm g{A2, B2, MTOK, DM, K2};
                pg8::StaticOrder S; S.init(MTOK, DM, (int)gridDim.x, (int)blockIdx.x);
                EpiResid E{H, H, modl + (3 * sb + 2) * DM, (ns < 6) ? Y : (bf16_t*)nullptr, ssq + (size_t)ns * MTOK,
                           p.norm_g + (size_t)(ns < 6 ? ns : 0) * DM, mod + (size_t)(ns < 6 ? nl : 0) * 8 * (NADA * DM) + (3 * nsb + 1) * DM, gsc, 0.f};
                pg8::gemm_phase<EpiResid>(lds, g, S, E);
                xcd_barrier(xbar);
            }
        }
    }
    ws = launder_p(ws);
    final_norm_phase((const bf16_t*)(ws + WS_H), p.out, p.final_g, (const float*)(ws + WS_SSQ) + (size_t)6 * MTOK, tid);
}

constexpr int LDS_BYTES = 131072 + 16;
extern "C" void kernel_launch(void* const* d_in, const int* in_sizes, int n_in, void* d_out, int out_size, void* d_ws, size_t ws_size, hipStream_t stream) {
    static int grid_blocks = 0;
    if (!grid_blocks) {
        int dev = 0, cus = 0, per_cu = 0;
        hipGetDevice(&dev);
        hipDeviceGetAttribute(&cus, hipDeviceAttributeMultiprocessorCount, dev);
        hipFuncSetAttribute((const void*)fwd_megakernel, hipFuncAttributeMaxDynamicSharedMemorySize, LDS_BYTES);
        hipOccupancyMaxActiveBlocksPerMultiprocessor(&per_cu, (const void*)fwd_megakernel, NTHR, LDS_BYTES);
        if (per_cu < 1) per_cu = 1;
        grid_blocks = cus * per_cu;
        if (ws_size < WS_END) fprintf(stderr, "kernel_launch: workspace too small (%zu < %zu)\n", ws_size, (size_t)WS_END);
    }
    Params p{};
    p.x = (const float*)d_in[0]; p.c = (const float*)d_in[1]; p.ada_w = (const float*)d_in[2]; p.ada_b = (const float*)d_in[3]; p.norm_g = (const float*)d_in[4];
    p.f1g = (const float*)d_in[5]; p.f1u = (const float*)d_in[6]; p.f1d = (const float*)d_in[7]; p.f2g = (const float*)d_in[8]; p.f2u = (const float*)d_in[9]; p.f2d = (const float*)d_in[10];
    p.w_in = (const float*)d_in[11]; p.sgu_ln_g = (const float*)d_in[12]; p.sgu_ln_b = (const float*)d_in[13]; p.sgu_w = (const float*)d_in[14]; p.sgu_b = (const float*)d_in[15];
    p.w_out = (const float*)d_in[16]; p.final_g = (const float*)d_in[17];
    p.out = (float*)d_out; p.ws = (unsigned char*)d_ws;
    (void)hipMemsetAsync((unsigned char*)d_ws + WS_BAR, 0, ZERO_BYTES, stream);
    void* args[] = {&p};
    hipError_t e = hipLaunchCooperativeKernel((const void*)fwd_megakernel, dim3(grid_blocks), dim3(NTHR), args, LDS_BYTES, stream);
    if (e != hipSuccess) fprintf(stderr, "cooperative launch failed: %s (grid %d)\n", hipGetErrorString(e), grid_blocks);
}
```

```cpp
#include <hip/hip_runtime.h>
#include <hip/hip_cooperative_groups.h>
#include <cstdio>
namespace cg = cooperative_groups;

#define LAS __attribute__((address_space(3)))
#define DI __device__ __forceinline__
typedef unsigned short bf16_t;
typedef short bf16x8 __attribute__((ext_vector_type(8)));
typedef short s16x4 __attribute__((ext_vector_type(4)));
typedef float f32x4 __attribute__((ext_vector_type(4)));
typedef float f32x2 __attribute__((ext_vector_type(2)));
typedef float f32x16 __attribute__((ext_vector_type(16)));
typedef unsigned u32x4 __attribute__((ext_vector_type(4)));
typedef unsigned u32x2 __attribute__((ext_vector_type(2)));

constexpr int DM = 1024, NB = 8, SEQ = 4096, MTOK = NB * SEQ, FF = 2816, INW = 2560, NADA = 9;
constexpr int NTHR = 512;
constexpr float EPS = 1e-6f;

constexpr size_t SZ_UP = (size_t)2 * FF * DM * 2;
constexpr size_t SZ_DN = (size_t)DM * FF * 2;
constexpr size_t SZ_IN = (size_t)INW * DM * 2;
constexpr size_t SZ_OUT = (size_t)DM * DM * 2;
constexpr size_t WS_UP = 0;
constexpr size_t WS_DN = WS_UP + 4 * SZ_UP;
constexpr size_t WS_IN = WS_DN + 4 * SZ_DN;
constexpr size_t WS_OUT = WS_IN + 2 * SZ_IN;
constexpr size_t WS_SGUW = WS_OUT + 2 * SZ_OUT;
constexpr size_t WS_MOD = WS_SGUW + (size_t)2 * 4 * 128 * 128 * 2;
constexpr size_t WS_ROPE = WS_MOD + (size_t)2 * 8 * 9216 * 4;
constexpr size_t WS_Y = WS_ROPE + (size_t)4096 * 32 * 8;
constexpr size_t WS_PG = WS_Y + (size_t)MTOK * DM * 2;
constexpr size_t WS_MIX = WS_PG + (size_t)MTOK * FF * 2;
constexpr size_t WS_H = WS_MIX + (size_t)MTOK * DM * 2;
constexpr size_t WS_BUP = WS_H + (size_t)MTOK * DM * 2;
constexpr size_t WS_BIN = WS_BUP + (size_t)4 * 8 * 2 * FF * 4;
constexpr size_t WS_BAR = WS_BIN + (size_t)2 * 8 * INW * 4;
constexpr size_t WS_SSQ = WS_BAR + 16384;
constexpr size_t ZERO_BYTES = 16384 + (size_t)7 * MTOK * 4;
constexpr size_t WS_END = WS_BAR + ZERO_BYTES;

struct Params {
    const float *x, *c, *ada_w, *ada_b, *norm_g, *f1g, *f1u, *f1d, *f2g, *f2u, *f2d, *w_in, *sgu_ln_g, *sgu_ln_b, *sgu_w, *sgu_b, *w_out, *final_g;
    float* out; unsigned char* ws;
};

DI int launder_v(int x) { asm volatile("" : "+v"(x)); return x; }
template <class T> DI T* launder_p(T* q) { size_t z = 0; asm volatile("" : "+s"(z)); return (T*)((unsigned char*)q + z); }
DI int fresh_lane() { unsigned z = 0; asm volatile("" : "+s"(z)); return (int)__builtin_amdgcn_mbcnt_hi(~0u, __builtin_amdgcn_mbcnt_lo(~0u, z)); }
DI int fresh_tid(int wave_s) { asm volatile("" : "+s"(wave_s)); return wave_s * 64 + fresh_lane(); }
DI float xshfl(float v, int mask) { const int idx = (fresh_lane() ^ mask) << 2; return __int_as_float(__builtin_amdgcn_ds_bpermute(idx, __float_as_int(v))); }
DI float bf2f(unsigned short v) { return __uint_as_float((unsigned)v << 16); }
DI unsigned short f2bf(float f) { unsigned u = __float_as_uint(f); u += 0x7fffu + ((u >> 16) & 1u); return (unsigned short)(u >> 16); }
DI unsigned cvt_pk_bf16(float lo, float hi) { unsigned r; asm("v_cvt_pk_bf16_f32 %0, %1, %2" : "=v"(r) : "v"(lo), "v"(hi)); return r; }
DI float fast_exp2(float x) { return __builtin_amdgcn_exp2f(x); }
DI float fast_rcp(float x) { return __builtin_amdgcn_rcpf(x); }
DI float silu_f(float x) { return x * fast_rcp(1.0f + fast_exp2(-1.4426950409f * x)); }
DI float gelu_tanh_f(float x) { const float t = 0.7978845608f * (x + 0.044715f * x * x * x); return x * fast_rcp(1.0f + fast_exp2(-2.8853900818f * t)); }

namespace pg8 {
constexpr int BM = 256, BK = 64, HALF = 128, HTB = HALF * BK * 2, STAGE_BYTES = 8 * HTB, NXCD = 8, WGM = 8;
DI int lds_byte(int r, int c) { const int st = (r >> 4) * 2 + (c >> 5), rr = r & 15, cc = c & 31, ob = rr * 64 + cc * 2; return st * 1024 + (ob ^ (((ob >> 9) & 1) << 5)); }
DI void stage_rc(int b, int& R, int& C) { const int st = b / 1024, sb = b % 1024, swz = sb ^ (((sb >> 9) & 1) << 5); R = (st >> 1) * 16 + swz / 64; C = (st & 1) * 32 + (swz % 64) / 2; }
DI int perm32(int rho) { const int n = rho >> 4, i = rho & 15; return 8 * (i >> 2) + 4 * n + (i & 3); }
struct Unit { int pm, pn; };
struct Gemm { const bf16_t* A; const bf16_t* Bt; int M, N, K; };
struct StaticOrder {
    int nM, nN, nwg, G, c;
    DI void init(int M, int N, int G_, int c_) { nM = M / BM; nN = N / BM; nwg = nM * nN; G = G_; c = c_; }
    DI bool next(int i, Unit& u) const {
        const long L = (long)i * G + c; if (L >= nwg) return false;
        int wgid = (int)L; { const int q = nwg / NXCD, r = nwg % NXCD, xcd = wgid % NXCD, off = wgid / NXCD; wgid = (xcd < r ? xcd * (q + 1) : r * (q + 1) + (xcd - r) * q) + off; }
        const int nig = WGM * nN, gid = wgid / nig, fm = gid * WGM, gsz = (nM - fm) < WGM ? (nM - fm) : WGM;
        u.pm = fm + ((wgid % nig) % gsz); u.pn = (wgid % nig) / gsz; return true;
    }
};

template <class Epi>
DI void gemm_phase(LAS unsigned char* lds, const Gemm g, const StaticOrder& S, const Epi& E, int tid_in) {
    const int tid = launder_v(tid_in), wid = __builtin_amdgcn_readfirstlane(tid >> 6), lane = tid & 63, wr = wid >> 2, wc = wid & 3, fr = lane & 15, fq = lane >> 4;
    const int K = g.K, nt = K / BK;
    unsigned voffA[2], voffB[2];
#pragma unroll
    for (int i = 0; i < 2; ++i) { int R, C; stage_rc(tid * 16 + i * 8192, R, C); const int Rb = Epi::PERM ? ((R & ~31) + perm32(R & 31)) : R;
        voffA[i] = (unsigned)(R * K + C) * 2u; voffB[i] = (unsigned)(Rb * K + C) * 2u; }
    const size_t kstep = (size_t)(BK * 2);
    const size_t hstep = (size_t)HALF * K * 2;
    const size_t tstep = 2 * hstep;
    const unsigned ldsw = (unsigned)wid * 1024u;
    const int aoff = lds_byte(wr * 64 + fr, fq * 8), boff = lds_byte(wc * 32 + fr, fq * 8);
#define PG8_SA(b, h) (((b) * 2 + (h)) * HTB)
#define PG8_SB(b, h) ((4 + (b) * 2 + (h)) * HTB)
#define PG8_STAGE(bufoff, gbase, voff) do { _Pragma("unroll") for (int _i = 0; _i < 2; ++_i) \
        __builtin_amdgcn_global_load_lds((const unsigned*)((const char*)(gbase) + (voff)[_i]), (LAS unsigned*)(lds + (bufoff) + ldsw + _i * 8192), 16, 0, 0); } while (0)
#define PG8_LDA(dst, b, h) do { _Pragma("unroll") for (int m = 0; m < 4; ++m) _Pragma("unroll") for (int k = 0; k < 2; ++k) dst[m][k] = *(const LAS bf16x8*)(lds + PG8_SA(b, h) + aoff + m * 2048 + k * 1024); } while (0)
#define PG8_LDB(dst, b, h) do { _Pragma("unroll") for (int n = 0; n < 2; ++n) _Pragma("unroll") for (int k = 0; k < 2; ++k) dst[n][k] = *(const LAS bf16x8*)(lds + PG8_SB(b, h) + boff + n * 2048 + k * 1024); } while (0)
#define PG8_MMA(ai, bj, At, Bt) do { __builtin_amdgcn_s_setprio(1); _Pragma("unroll") for (int m = 0; m < 4; ++m) _Pragma("unroll") for (int n = 0; n < 2; ++n) _Pragma("unroll") for (int k = 0; k < 2; ++k) \
        acc[ai][bj][m][n] = __builtin_amdgcn_mfma_f32_16x16x32_bf16(Bt[n][k], At[m][k], acc[ai][bj][m][n], 0, 0, 0); __builtin_amdgcn_s_setprio(0); } while (0)
#define PG8_WAIT_V(n) asm volatile("s_waitcnt vmcnt(" #n ")" ::: "memory")
#define PG8_WAIT_L(n) asm volatile("s_waitcnt lgkmcnt(" #n ")" ::: "memory")
#define PG8_BAR __builtin_amdgcn_s_barrier()
#define PG8_SCHED __builtin_amdgcn_sched_barrier(0)
    Unit cur, nxt; int ui = 0;
    if (!S.next(0, cur)) return;
    f32x4 acc[2][2][4][2];
#pragma unroll
    for (int a = 0; a < 2; ++a)
#pragma unroll
        for (int b = 0; b < 2; ++b)
#pragma unroll
            for (int m = 0; m < 4; ++m)
#pragma unroll
                for (int n = 0; n < 2; ++n) acc[a][b][m][n] = (f32x4){0.f, 0.f, 0.f, 0.f};
    bf16x8 At[4][2], B0[2][2], B1[2][2];
    const char* cA = (const char*)g.A + (size_t)cur.pm * tstep; const char* cB = (const char*)g.Bt + (size_t)cur.pn * tstep;
    PG8_STAGE(PG8_SB(0, 0), cB, voffB); PG8_STAGE(PG8_SA(0, 0), cA, voffA); PG8_STAGE(PG8_SB(0, 1), cB + hstep, voffB); PG8_STAGE(PG8_SA(0, 1), cA + hstep, voffA);
    if (wr == 1) PG8_BAR;
    PG8_WAIT_V(4); PG8_BAR;
    PG8_STAGE(PG8_SB(1, 0), cB + kstep, voffB); PG8_STAGE(PG8_SA(1, 0), cA + kstep, voffA); PG8_STAGE(PG8_SB(1, 1), cB + hstep + kstep, voffB);
    PG8_WAIT_V(6); PG8_BAR;
    for (;;) {
        const bool has_next = S.next(ui + 1, nxt);
        const char* nA = has_next ? (const char*)g.A + (size_t)nxt.pm * tstep : cA; const char* nB = has_next ? (const char*)g.Bt + (size_t)nxt.pn * tstep : cB;
        for (int t = 0; t < nt; t += 2) {
            const bool last = (t == nt - 2);
            const char* a1 = cA + (size_t)(t + 1) * kstep;
            const char* a2 = last ? nA : cA + (size_t)(t + 2) * kstep; const char* b2 = last ? nB : cB + (size_t)(t + 2) * kstep;
            const char* a3 = a2 + kstep; const char* b3 = b2 + kstep;
            PG8_LDB(B0, 0, 0); PG8_SCHED; PG8_LDA(At, 0, 0); PG8_STAGE(PG8_SA(1, 1), a1 + hstep, voffA);
            PG8_WAIT_L(8); PG8_BAR; PG8_WAIT_L(0); PG8_MMA(0, 0, At, B0); PG8_BAR; PG8_SCHED;
            PG8_LDB(B1, 0, 1); PG8_STAGE(PG8_SB(0, 0), b2, voffB);
            PG8_BAR; PG8_WAIT_L(0); PG8_MMA(0, 1, At, B1); PG8_BAR;
            PG8_LDA(At, 0, 1); PG8_STAGE(PG8_SA(0, 0), a2, voffA);
            PG8_BAR; PG8_WAIT_L(0); PG8_MMA(1, 0, At, B0); PG8_BAR; PG8_SCHED;
            PG8_STAGE(PG8_SB(0, 1), b2 + hstep, voffB);
            PG8_WAIT_V(6); PG8_BAR; PG8_MMA(1, 1, At, B1); PG8_BAR;
            PG8_LDB(B0, 1, 0); PG8_SCHED; PG8_LDA(At, 1, 0); PG8_STAGE(PG8_SA(0, 1), a2 + hstep, voffA);
            PG8_WAIT_L(8); PG8_BAR; PG8_WAIT_L(0); PG8_MMA(0, 0, At, B0); PG8_BAR; PG8_SCHED;
            PG8_LDB(B1, 1, 1); PG8_STAGE(PG8_SB(1, 0), b3, voffB);
            PG8_BAR; PG8_WAIT_L(0); PG8_MMA(0, 1, At, B1); PG8_BAR;
            PG8_LDA(At, 1, 1); PG8_STAGE(PG8_SA(1, 0), a3, voffA);
            PG8_BAR; PG8_WAIT_L(0); PG8_MMA(1, 0, At, B0); PG8_BAR; PG8_SCHED;
            PG8_STAGE(PG8_SB(1, 1), b3 + hstep, voffB);
            PG8_WAIT_V(6); PG8_BAR; PG8_MMA(1, 1, At, B1); PG8_BAR;
        }
        E(acc, cur, wr, wc, fr, fq);
        if (!has_next) break;
#pragma unroll
        for (int a = 0; a < 2; ++a)
#pragma unroll
            for (int b = 0; b < 2; ++b)
#pragma unroll
                for (int m = 0; m < 4; ++m)
#pragma unroll
                    for (int n = 0; n < 2; ++n) acc[a][b][m][n] = (f32x4){0.f, 0.f, 0.f, 0.f};
        cur = nxt; cA = nA; cB = nB; ++ui;
    }
    PG8_WAIT_V(0);
    if (wr == 0) PG8_BAR;
    PG8_BAR;
#undef PG8_SA
#undef PG8_SB
#undef PG8_STAGE
#undef PG8_LDA
#undef PG8_LDB
#undef PG8_MMA
#undef PG8_WAIT_V
#undef PG8_WAIT_L
#undef PG8_BAR
#undef PG8_SCHED
}
}

struct EpiSwiglu {
    static constexpr bool PERM = true;
    bf16_t* G; const float* ssq; const float* bias;
    DI void operator()(const f32x4 (&acc)[2][2][4][2], const pg8::Unit& u, int wr, int wc, int fr, int fq) const {
        const int row0 = u.pm * 256 + wr * 64 + fr, col0 = u.pn * 128 + wc * 32 + 8 * fq, b = (u.pm * 256) / SEQ;
        const float* bp = bias + (size_t)b * (2 * FF) + u.pn * 256 + wc * 32 + 8 * fq;
        const f32x4 bg0 = *(const f32x4*)bp, bg1 = *(const f32x4*)(bp + 4), bu0 = *(const f32x4*)(bp + 128), bu1 = *(const f32x4*)(bp + 132);
        float sq[8];
#pragma unroll
        for (int i = 0; i < 8; ++i) sq[i] = ssq[row0 + (i >> 2) * 128 + (i & 3) * 16];
#pragma unroll
        for (int ai = 0; ai < 2; ++ai)
#pragma unroll
            for (int m = 0; m < 4; ++m) {
                bf16_t* rowp = G + (size_t)(row0 + ai * 128 + m * 16) * FF + col0;
                const float rstd = rsqrtf(sq[ai * 4 + m] * (1.0f / DM) + EPS);
                const f32x4 g0 = acc[ai][0][m][0] * rstd + bg0, g1 = acc[ai][0][m][1] * rstd + bg1, u0 = acc[ai][1][m][0] * rstd + bu0, u1 = acc[ai][1][m][1] * rstd + bu1;
                u32x4 w;
                w.x = cvt_pk_bf16(silu_f(g0[0]) * u0[0], silu_f(g0[1]) * u0[1]); w.y = cvt_pk_bf16(silu_f(g0[2]) * u0[2], silu_f(g0[3]) * u0[3]);
                w.z = cvt_pk_bf16(silu_f(g1[0]) * u1[0], silu_f(g1[1]) * u1[1]); w.w = cvt_pk_bf16(silu_f(g1[2]) * u1[2], silu_f(g1[3]) * u1[3]);
                *(u32x4*)rowp = w;
            }
    }
};
struct EpiResid {
    static constexpr bool PERM = true;
    const bf16_t* hin; bf16_t* hout; const float* gate;
    bf16_t* ynext; float* ssqn; const float* gnext; const float* scnext;
    float gscale, pad_;
    DI void operator()(const f32x4 (&acc)[2][2][4][2], const pg8::Unit& u, int wr, int wc, int fr, int fq) const {
        const int row0 = u.pm * 256 + wr * 64 + fr, col0 = u.pn * 256 + wc * 32 + 8 * fq, b = (u.pm * 256) / SEQ;
        const bool has_y = ynext != nullptr;
        float rs[8];
#pragma unroll
        for (int it = 0; it < 8; ++it) rs[it] = 0.f;
#pragma unroll
        for (int bj = 0; bj < 2; ++bj) {
            u32x4 hb[8];
#pragma unroll
            for (int it = 0; it < 8; ++it) hb[it] = *(const u32x4*)(hin + (size_t)(row0 + (it >> 2) * 128 + (it & 3) * 16) * DM + col0 + bj * 128);
            const float* gp = gate + (size_t)b * (NADA * DM) + col0 + bj * 128;
            const f32x4 gv0 = *(const f32x4*)gp * gscale, gv1 = *(const f32x4*)(gp + 4) * gscale;
            const float* np = gnext + col0 + bj * 128; const float* sp = scnext + (size_t)b * (NADA * DM) + col0 + bj * 128;
            const f32x4 gm0 = *(const f32x4*)np * (*(const f32x4*)sp + 1.0f), gm1 = *(const f32x4*)(np + 4) * (*(const f32x4*)(sp + 4) + 1.0f);
            __builtin_amdgcn_sched_barrier(0);
#pragma unroll
            for (int it = 0; it < 8; ++it) {
                const int ai = it >> 2, m = it & 3;
                const size_t off = (size_t)(row0 + ai * 128 + m * 16) * DM + col0 + bj * 128;
                const u32x4 q = hb[it];
                f32x4 h0 = {__uint_as_float(q.x << 16), __uint_as_float(q.x & 0xffff0000u), __uint_as_float(q.y << 16), __uint_as_float(q.y & 0xffff0000u)};
                f32x4 h1 = {__uint_as_float(q.z << 16), __uint_as_float(q.z & 0xffff0000u), __uint_as_float(q.w << 16), __uint_as_float(q.w & 0xffff0000u)};
                h0 += gv0 * acc[ai][bj][m][0]; h1 += gv1 * acc[ai][bj][m][1];
                rs[it] += h0[0] * h0[0] + h0[1] * h0[1] + h0[2] * h0[2] + h0[3] * h0[3] + h1[0] * h1[0] + h1[1] * h1[1] + h1[2] * h1[2] + h1[3] * h1[3];
                u32x4 wh; wh.x = cvt_pk_bf16(h0[0], h0[1]); wh.y = cvt_pk_bf16(h0[2], h0[3]); wh.z = cvt_pk_bf16(h1[0], h1[1]); wh.w = cvt_pk_bf16(h1[2], h1[3]);
                *(u32x4*)(hout + off) = wh;
                if (has_y) { const f32x4 a0 = h0 * gm0, a1 = h1 * gm1;
                    u32x4 wy; wy.x = cvt_pk_bf16(a0[0], a0[1]); wy.y = cvt_pk_bf16(a0[2], a0[3]); wy.z = cvt_pk_bf16(a1[0], a1[1]); wy.w = cvt_pk_bf16(a1[2], a1[3]);
                    *(u32x4*)(ynext + off) = wy; }
            }
            __builtin_amdgcn_sched_barrier(0);
        }
#pragma unroll
        for (int it = 0; it < 8; ++it) {
            float v = rs[it]; v += xshfl(v, 16); v += xshfl(v, 32);
            if (fq == 0) (void)__hip_atomic_fetch_add(ssqn + row0 + (it >> 2) * 128 + (it & 3) * 16, v, __ATOMIC_RELAXED, __HIP_MEMORY_SCOPE_AGENT);
        }
    }
};
struct EpiIn {
    static constexpr bool PERM = true;
    bf16_t* P; const float* rope; const float* ssq; const float* bias;
    DI void operator()(const f32x4 (&acc)[2][2][4][2], const pg8::Unit& u, int wr, int wc, int fr, int fq) const {
        const int row0 = u.pm * 256 + wr * 64 + fr, col0 = u.pn * 256 + wc * 32 + 8 * fq, kind = u.pn >> 1, b = (u.pm * 256) / SEQ;
        const int i0 = 16 * (wc & 1) + 4 * fq;
        const bool is_rope = (kind == 2 || kind == 3);
        const float* bp = bias + (size_t)b * INW + col0;
        const f32x4 bv00 = *(const f32x4*)bp, bv01 = *(const f32x4*)(bp + 4), bv10 = *(const f32x4*)(bp + 128), bv11 = *(const f32x4*)(bp + 132);
        float sq[8];
#pragma unroll
        for (int i = 0; i < 8; ++i) sq[i] = ssq[row0 + (i >> 2) * 128 + (i & 3) * 16];
        const float qs = (kind == 2) ? 0.125f * 1.4426950409f : 1.0f;
        f32x4 cs0 = {1.f, 0.f, 1.f, 0.f}, cs1 = {1.f, 0.f, 1.f, 0.f};
        if (is_rope) { const f32x4* rp = (const f32x4*)(rope + ((size_t)(row0 & (SEQ - 1)) * 32 + i0) * 2); cs0 = rp[0]; cs1 = rp[1]; }
#pragma unroll
        for (int it = 0; it < 8; ++it) {
            const int ai = it >> 2, m = it & 3;
            const int row = row0 + ai * 128 + m * 16;
            bf16_t* rowp = P + (size_t)row * INW + col0;
            const float rstd = rsqrtf(sq[it] * (1.0f / DM) + EPS);
            f32x4 cn0 = cs0, cn1 = cs1;
            if (is_rope && it < 7) { const int row2 = row0 + ((it + 1) >> 2) * 128 + ((it + 1) & 3) * 16;
                const f32x4* rp = (const f32x4*)(rope + ((size_t)(row2 & (SEQ - 1)) * 32 + i0) * 2); cn0 = rp[0]; cn1 = rp[1]; }
            __builtin_amdgcn_sched_barrier(0);
#pragma unroll
            for (int bj = 0; bj < 2; ++bj) {
                f32x4 v0 = acc[ai][bj][m][0] * rstd + (bj ? bv10 : bv00), v1 = acc[ai][bj][m][1] * rstd + (bj ? bv11 : bv01);
                if (kind <= 1) {
#pragma unroll
                    for (int j = 0; j < 4; ++j) { v0[j] = gelu_tanh_f(v0[j]); v1[j] = gelu_tanh_f(v1[j]); }
                } else if (kind <= 3) {
#pragma unroll
                    for (int j = 0; j < 4; ++j) { const float cj = (j < 2 ? cs0 : cs1)[(j & 1) * 2], sj = (j < 2 ? cs0 : cs1)[(j & 1) * 2 + 1];
                        const float x1 = v0[j], x2 = v1[j]; v0[j] = (x1 * cj - x2 * sj) * qs; v1[j] = (x2 * cj + x1 * sj) * qs; }
                }
                u32x4 w; w.x = cvt_pk_bf16(v0[0], v0[1]); w.y = cvt_pk_bf16(v0[2], v0[3]); w.z = cvt_pk_bf16(v1[0], v1[1]); w.w = cvt_pk_bf16(v1[2], v1[3]);
                *(u32x4*)(rowp + bj * 128) = w;
            }
            cs0 = cn0; cs1 = cn1;
        }
    }
};

DI void tr_tile(const float* src, int ld_src, int srccol0, int k0, bf16_t* dst, int ld_dst, int n0, bool rperm, LAS float* tile, int tid) {
#pragma unroll
    for (int i = 0; i < 2; ++i) {
        const int idx = tid + i * NTHR, row = idx >> 4, c4 = idx & 15;
        const f32x4 v = *(const f32x4*)(src + (size_t)(k0 + row) * ld_src + srccol0 + c4 * 4);
        LAS float* t = tile + row * 65 + c4 * 4; t[0] = v[0]; t[1] = v[1]; t[2] = v[2]; t[3] = v[3];
    }
    __syncthreads();
    const int p = tid >> 3, kc = (tid & 7) * 8;
    const int pp = rperm ? (4 * (p >> 3) + (p & 3) + 32 * ((p >> 2) & 1)) : p;
    float v[8];
#pragma unroll
    for (int j = 0; j < 8; ++j) v[j] = tile[(kc + j) * 65 + pp];
    u32x4 w; w.x = cvt_pk_bf16(v[0], v[1]); w.y = cvt_pk_bf16(v[2], v[3]); w.z = cvt_pk_bf16(v[4], v[5]); w.w = cvt_pk_bf16(v[6], v[7]);
    *(u32x4*)(dst + (size_t)(n0 + p) * ld_dst + k0 + kc) = w;
    __syncthreads();
}

constexpr int IT_MOD = 288;
constexpr int IT_ROPE = 256, IT_SGUW = 256;
constexpr int T_UP = 88 * 16, T_DN = 16 * 44, T_IN = 40 * 16, T_OUT = 16 * 16;
constexpr int IT_UP0 = IT_MOD + IT_ROPE + IT_SGUW, IT_DN0 = IT_UP0 + 4 * T_UP, IT_IN0 = IT_DN0 + 4 * T_DN, IT_OUT0 = IT_IN0 + 2 * T_IN, IT_END = IT_OUT0 + 2 * T_OUT;

DI void prelude_phase(const Params& p, LAS unsigned char* lds, int tid) {
    unsigned char* ws = p.ws;
    for (int it = blockIdx.x; it < IT_END; it += gridDim.x) {
        if (it < IT_MOD) {
            const int l = it / 144, cb = it % 144;
            LAS float* s = (LAS float*)lds; LAS float* red = (LAS float*)(lds + 32768);
            for (int i = tid; i < NB * DM; i += NTHR) s[i] = silu_f(p.c[i]);
            __syncthreads();
            const int cp = tid & 31, kg = tid >> 5;
            float a[8][2];
#pragma unroll
            for (int b = 0; b < 8; ++b) { a[b][0] = 0.f; a[b][1] = 0.f; }
            const float* w = p.ada_w + (size_t)l * DM * (NADA * DM) + (size_t)(kg * 64) * (NADA * DM) + cb * 64 + cp * 2;
#pragma unroll 4
            for (int k = 0; k < 64; ++k) {
                const f32x2 wv = *(const f32x2*)(w + (size_t)k * (NADA * DM));
#pragma unroll
                for (int b = 0; b < 8; ++b) { const float sv = s[b * DM + kg * 64 + k]; a[b][0] += sv * wv.x; a[b][1] += sv * wv.y; }
            }
#pragma unroll
            for (int b = 0; b < 8; ++b) { red[(kg * 8 + b) * 64 + cp * 2] = a[b][0]; red[(kg * 8 + b) * 64 + cp * 2 + 1] = a[b][1]; }
            __syncthreads();
            { const int b = tid >> 6, col = tid & 63; float sum = 0.f;
#pragma unroll
              for (int g = 0; g < 16; ++g) sum += red[(g * 8 + b) * 64 + col];
              const int n = cb * 64 + col;
              ((float*)(ws + WS_MOD))[((size_t)l * 8 + b) * (NADA * DM) + n] = sum + p.ada_b[(size_t)l * (NADA * DM) + n]; }
            __syncthreads();
        } else if (it < IT_MOD + IT_ROPE) {
            const int idx = (it - IT_MOD) * NTHR + tid, pos = idx >> 5, i = idx & 31;
            const float inv = exp2f(-(float)i * (13.287712379549449f / 32.0f));
            const float ang = (float)pos * inv;
            const double rev = (double)ang * 0.15915494309189535;
            const float fr = (float)(rev - floor(rev));
            f32x2 cs; cs.x = __builtin_amdgcn_cosf(fr); cs.y = __builtin_amdgcn_sinf(fr);
            ((f32x2*)(ws + WS_ROPE))[idx] = cs;
        } else if (it < IT_UP0) {
            const int idx = (it - IT_MOD - IT_ROPE) * NTHR + tid, j = idx & 127, i = (idx >> 7) & 127;
            ((bf16_t*)(ws + WS_SGUW))[idx] = (j <= i) ? f2bf(p.sgu_w[idx]) : (bf16_t)0;
        } else if (it < IT_DN0) {
            const int r = it - IT_UP0, lf = r / T_UP, t = r % T_UP, nb = t >> 4, kb = t & 15, l = lf >> 1, f = lf & 1;
            const int n0 = nb * 64, tl = n0 >> 8, half = (n0 >> 7) & 1, j0 = n0 & 127;
            const float* src = (f ? (half ? p.f2u : p.f2g) : (half ? p.f1u : p.f1g)) + (size_t)l * DM * FF;
            tr_tile(src, FF, tl * 128 + j0, kb * 64, (bf16_t*)(ws + WS_UP + (size_t)lf * SZ_UP), DM, n0, false, (LAS float*)lds, tid);
        } else if (it < IT_IN0) {
            const int r = it - IT_DN0, lf = r / T_DN, t = r % T_DN, nb = t / 44, kb = t % 44, l = lf >> 1, f = lf & 1;
            const float* src = (f ? p.f2d : p.f1d) + (size_t)l * FF * DM;
            tr_tile(src, DM, nb * 64, kb * 64, (bf16_t*)(ws + WS_DN + (size_t)lf * SZ_DN), FF, nb * 64, false, (LAS float*)lds, tid);
        } else if (it < IT_OUT0) {
            const int r = it - IT_IN0, l = r / T_IN, t = r % T_IN, nb = t >> 4, kb = t & 15, n0 = nb * 64;
            tr_tile(p.w_in + (size_t)l * DM * INW, INW, n0, kb * 64, (bf16_t*)(ws + WS_IN + (size_t)l * SZ_IN), DM, n0, (n0 >= 1024 && n0 < 2048), (LAS float*)lds, tid);
        } else {
            const int r = it - IT_OUT0, l = r / T_OUT, t = r % T_OUT, nb = t >> 4, kb = t & 15;
            tr_tile(p.w_out + (size_t)l * DM * DM, DM, nb * 64, kb * 64, (bf16_t*)(ws + WS_OUT + (size_t)l * SZ_OUT), DM, nb * 64, false, (LAS float*)lds, tid);
        }
    }
}

DI float wave_sum(float v) {
#pragma unroll
    for (int o = 32; o >= 1; o >>= 1) v += xshfl(v, o);
    return v;
}
DI void norm0_phase(const float* h, const float* g, const float* sc, bf16_t* y, float* ssq, bf16_t* hb, int tid) {
    tid = launder_v(tid);
    const int wave = tid >> 6, lane = tid & 63;
    for (int row = blockIdx.x * 8 + wave; row < MTOK; row += gridDim.x * 8) {
        const int b = row / SEQ;
        const float* hp = h + (size_t)row * DM;
        f32x4 v[4]; float ss = 0.f;
#pragma unroll
        for (int i = 0; i < 4; ++i) { v[i] = *(const f32x4*)(hp + i * 256 + lane * 4); ss += v[i][0] * v[i][0] + v[i][1] * v[i][1] + v[i][2] * v[i][2] + v[i][3] * v[i][3]; }
        ss = wave_sum(ss);
        if (lane == 0) ssq[row] = ss;
#pragma unroll
        for (int i = 0; i < 4; ++i) {
            const int col = i * 256 + lane * 4;
            const f32x4 gv = *(const f32x4*)(g + col), sv = *(const f32x4*)(sc + (size_t)b * (NADA * DM) + col);
            const f32x4 o = v[i] * gv * (sv + 1.0f);
            u32x2 w; w.x = cvt_pk_bf16(o[0], o[1]); w.y = cvt_pk_bf16(o[2], o[3]);
            *(u32x2*)(y + (size_t)row * DM + col) = w;
            u32x2 wx; wx.x = cvt_pk_bf16(v[i][0], v[i][1]); wx.y = cvt_pk_bf16(v[i][2], v[i][3]);
            *(u32x2*)(hb + (size_t)row * DM + col) = wx;
        }
    }
}
DI void bias_phase(unsigned char* ws, int tid) {
    tid = launder_v(tid);
    const int wave = tid >> 6, lane = tid & 63;
    const float* mod = (const float*)(ws + WS_MOD);
    for (int ri = blockIdx.x * 8 + wave; ri < 4 * 2 * FF + 2 * INW; ri += gridDim.x * 8) {
        const bf16_t* bt; const float* sh; float* outp; int bstride;
        if (ri < 4 * 2 * FF) { const int lf = ri / (2 * FF), n = ri % (2 * FF), l = lf >> 1, sb = (lf & 1) * 2;
            bt = (const bf16_t*)(ws + WS_UP + (size_t)lf * SZ_UP) + (size_t)n * DM; sh = mod + (size_t)l * 8 * (NADA * DM) + (3 * sb) * DM;
            outp = (float*)(ws + WS_BUP) + (size_t)lf * 8 * (2 * FF) + n; bstride = 2 * FF;
        } else { const int r2 = ri - 4 * 2 * FF, l = r2 / INW, n = r2 % INW;
            bt = (const bf16_t*)(ws + WS_IN + (size_t)l * SZ_IN) + (size_t)n * DM; sh = mod + (size_t)l * 8 * (NADA * DM) + 3 * DM;
            outp = (float*)(ws + WS_BIN) + (size_t)l * 8 * INW + n; bstride = INW; }
        float w[16];
#pragma unroll
        for (int i = 0; i < 2; ++i) { const u32x4 q = *(const u32x4*)(bt + lane * 16 + 8 * i);
#pragma unroll
            for (int k = 0; k < 4; ++k) { w[8 * i + 2 * k] = __uint_as_float(q[k] << 16); w[8 * i + 2 * k + 1] = __uint_as_float(q[k] & 0xffff0000u); } }
        float res = 0.f;
#pragma unroll
        for (int b = 0; b < 8; ++b) {
            float d = 0.f;
#pragma unroll
            for (int i = 0; i < 4; ++i) { const f32x4 sv = *(const f32x4*)(sh + (size_t)b * (NADA * DM) + lane * 16 + 4 * i); d += sv[0] * w[4 * i] + sv[1] * w[4 * i + 1] + sv[2] * w[4 * i + 2] + sv[3] * w[4 * i + 3]; }
            d = wave_sum(d);
            res = (lane == b) ? d : res;
        }
        if (lane < 8) outp[(size_t)lane * bstride] = res;
    }
}
DI void final_norm_phase(const bf16_t* h, float* out, const float* g, const float* ssq, int tid) {
    tid = launder_v(tid);
    const int wave = tid >> 6, lane = tid & 63;
    for (int row = blockIdx.x * 8 + wave; row < MTOK; row += gridDim.x * 8) {
        const float rstd = rsqrtf(ssq[row] * (1.0f / DM) + EPS);
#pragma unroll
        for (int i = 0; i < 2; ++i) {
            const int col = i * 512 + lane * 8;
            const u32x4 q = *(const u32x4*)(h + (size_t)row * DM + col);
            const f32x4 g0 = *(const f32x4*)(g + col), g1 = *(const f32x4*)(g + col + 4);
            const f32x4 h0 = {__uint_as_float(q.x << 16), __uint_as_float(q.x & 0xffff0000u), __uint_as_float(q.y << 16), __uint_as_float(q.y & 0xffff0000u)};
            const f32x4 h1 = {__uint_as_float(q.z << 16), __uint_as_float(q.z & 0xffff0000u), __uint_as_float(q.w << 16), __uint_as_float(q.w & 0xffff0000u)};
            *(f32x4*)(out + (size_t)row * DM + col) = h0 * rstd * g0; *(f32x4*)(out + (size_t)row * DM + col + 4) = h1 * rstd * g1;
        }
    }
}

#define MFMA32(a, b, c) __builtin_amdgcn_mfma_f32_32x32x16_bf16((a), (b), (c), 0, 0, 0)
DI bf16x8 pack8(const f32x16& x, int s) {
    u32x4 p; p.x = cvt_pk_bf16(x[8 * s], x[8 * s + 1]); p.y = cvt_pk_bf16(x[8 * s + 2], x[8 * s + 3]); p.z = cvt_pk_bf16(x[8 * s + 4], x[8 * s + 5]); p.w = cvt_pk_bf16(x[8 * s + 6], x[8 * s + 7]);
    return __builtin_bit_cast(bf16x8, p);
}

DI void sgu_item(const Params& p, int l, int item, LAS unsigned char* lds, int tid) {
    tid = launder_v(tid); unsigned char* wsl = launder_p(p.ws);
    const bf16_t* P = (const bf16_t*)(wsl + WS_PG); bf16_t* mixed = (bf16_t*)(wsl + WS_MIX);
    const int b = item >> 7, rem = item & 127, chunk = rem >> 2, hh = rem & 3;
    const size_t T0 = (size_t)b * SEQ + chunk * 128;
    {
        const int j = tid >> 2, qd = tid & 3;
        const bf16_t* vp = P + (T0 + j) * INW + 512 + 128 * hh + 32 * qd;
        float v[32];
#pragma unroll
        for (int i = 0; i < 4; ++i) { const u32x4 w = *(const u32x4*)(vp + 8 * i);
#pragma unroll
            for (int k = 0; k < 4; ++k) { v[8 * i + 2 * k] = __uint_as_float(w[k] << 16); v[8 * i + 2 * k + 1] = __uint_as_float(w[k] & 0xffff0000u); } }
        float sum = 0.f;
#pragma unroll
        for (int i = 0; i < 32; ++i) sum += v[i];
        sum += xshfl(sum, 1); sum += xshfl(sum, 2);
        const float mu = sum * (1.0f / 128.0f);
        float sq = 0.f;
#pragma unroll
        for (int i = 0; i < 32; ++i) { const float d = v[i] - mu; sq += d * d; }
        sq += xshfl(sq, 1); sq += xshfl(sq, 2);
        const float rstd = rsqrtf(sq * (1.0f / 128.0f) + EPS);
        const float* lg = p.sgu_ln_g + ((size_t)l * 4 + hh) * 128 + 32 * qd; const float* lb = p.sgu_ln_b + ((size_t)l * 4 + hh) * 128 + 32 * qd;
#pragma unroll
        for (int i = 0; i < 32; ++i) { const float o = (v[i] - mu) * rstd * lg[i] + lb[i]; *(LAS bf16_t*)(lds + (32 * qd + i) * 272 + j * 2) = f2bf(o); }
    }
    __syncthreads();
    {
        const int wave = __builtin_amdgcn_readfirstlane(tid >> 6), lane = tid & 63, r = lane & 31, h = lane >> 5;
        const int c0 = 32 * (wave & 3);
        const bf16_t* Wsb = (const bf16_t*)(wsl + WS_SGUW) + ((size_t)l * 4 + hh) * 128 * 128;
#pragma unroll
        for (int q = 0; q < 2; ++q) {
            const int itile = (wave < 4) ? (q ? 3 : 0) : (q ? 2 : 1), i0 = 32 * itile;
            f32x16 acc;
#pragma unroll
            for (int i = 0; i < 16; ++i) acc[i] = 0.f;
            const bf16_t* wrow = Wsb + (size_t)(i0 + r) * 128 + 8 * h;
            const LAS unsigned char* arow = lds + (c0 + r) * 272 + 16 * h;
            const int nks = 2 * (itile + 1);
            bf16x8 wf[8];
#pragma unroll
            for (int ks = 0; ks < 8; ++ks) wf[ks] = *(const bf16x8*)(wrow + (ks < nks ? ks : 0) * 16);
            const float bs = p.sgu_b[((size_t)l * 4 + hh) * 128 + i0 + r];
            const size_t tok = T0 + i0 + r;
            u32x2 uwv[4];
#pragma unroll
            for (int g = 0; g < 4; ++g) uwv[g] = *(const u32x2*)(P + tok * INW + 128 * hh + c0 + 8 * g + 4 * h);
#pragma unroll
            for (int ks = 0; ks < 8; ++ks) if (ks < nks) {
                const bf16x8 af = *(const LAS bf16x8*)(arow + ks * 32);
                acc = MFMA32(af, wf[ks], acc);
            }
#pragma unroll
            for (int g = 0; g < 4; ++g) {
                const int c = c0 + 8 * g + 4 * h;
                const u32x2 uw = uwv[g];
                const float u0 = __uint_as_float(uw.x << 16), u1 = __uint_as_float(uw.x & 0xffff0000u), u2 = __uint_as_float(uw.y << 16), u3 = __uint_as_float(uw.y & 0xffff0000u);
                u32x2 w; w.x = cvt_pk_bf16(u0 * (acc[4 * g] + bs), u1 * (acc[4 * g + 1] + bs)); w.y = cvt_pk_bf16(u2 * (acc[4 * g + 2] + bs), u3 * (acc[4 * g + 3] + bs));
                *(u32x2*)(mixed + tok * DM + 128 * hh + c) = w;
            }
        }
    }
    __syncthreads();
}

constexpr int AT_OPITCH = 136, AT_LSE_OFF = 512 * AT_OPITCH, AT_V_OFF = AT_LSE_OFF + 2048, AT_WBYTES = 8192;
constexpr int LDS_BARW = AT_V_OFF + 8 * AT_WBYTES;
DI void attn_item(const Params& p, int item, LAS unsigned char* lds, int tid) {
    tid = launder_v(tid); unsigned char* wsl = launder_p(p.ws);
    const bf16_t* P = (const bf16_t*)(wsl + WS_PG); bf16_t* mixed = (bf16_t*)(wsl + WS_MIX);
    const int wave = __builtin_amdgcn_readfirstlane(tid >> 6), lane = tid & 63, r = lane & 31, h = lane >> 5;
    const int xcd = item & 7, li = item >> 3, bh = (li >> 3) * 8 + xcd, sp = li & 7, b = bh >> 3, hd = bh & 7;
    const bf16_t* Pb = P + (size_t)b * SEQ * INW;
    LAS unsigned char* Ost = lds; LAS float* Lse = (LAS float*)(lds + AT_LSE_OFF);
    LAS unsigned char* Kimg = lds + AT_V_OFF + wave * AT_WBYTES; LAS unsigned char* Vimg = Kimg + 4096;
    const int lrow = lane >> 3, lch = lane & 7;
    int wo[4];
#pragma unroll
    for (int s = 0; s < 4; ++s) wo[s] = (8 * s + lrow) * 128 + 16 * (lch ^ ((((lrow >> 1) & 1) << 2) | ((2 * s + (lrow >> 2)) & 3)));
    const int kro = 128 * r + 64 * (h ^ ((r >> 1) & 1)), krx = (r >> 2) & 3;
    const int trq = (lane >> 2) & 3, trp = lane & 3, dhalf = (lane >> 4) & 1;
    int trb[2][2];
#pragma unroll
    for (int sec = 0; sec < 2; ++sec)
#pragma unroll
        for (int dt = 0; dt < 2; ++dt)
            trb[sec][dt] = 128 * (8 * sec + 4 * h + trq) + 16 * ((4 * dt + 2 * dhalf + (trp >> 1)) ^ ((((trq >> 1) & 1) << 2) | ((2 * sec + h) & 3))) + 8 * (trp & 1);
    bf16x8 qf[4]; u32x4 qn[4]; u32x4 kf[3][4]; u32x4 vr[3][4];
#define AT_DESC(t, ldil_, dil_, res_, qtl_, Pq0_, jmin_) const int ldil_ = 2 * ((t) >> 1), dil_ = 1 << ldil_, _tk##res_ = wave + 8 * ((t) & 1), res_ = _tk##res_ & (dil_ - 1), qtl_ = _tk##res_ >> ldil_, \
        Pq0_ = ((sp * 512) >> ldil_) + 32 * qtl_, jmin_ = (Pq0_ >= 128) ? 0 : 4 - (Pq0_ >> 5)
#define AT_LOADX(res_, dil_, Pq0_, jmin_, j, bi) do { const int _jj = ((j) < jmin_) ? jmin_ : (j); const int _P0 = Pq0_ + 32 * (_jj - 4); \
        const bf16_t* _kp = Pb + (size_t)(res_ + dil_ * (_P0 + lrow)) * INW + 1536 + 64 * hd + 8 * lch; \
        _Pragma("unroll") for (int _s = 0; _s < 4; ++_s) { kf[bi][_s] = *(const u32x4*)(_kp + (size_t)(8 * _s * dil_) * INW); vr[bi][_s] = *(const u32x4*)(_kp + (size_t)(8 * _s * dil_) * INW + 512); } } while (0)
#define AT_LOADQ(dst, res_, dil_, Pq0_) do { const bf16_t* _qp = Pb + (size_t)(res_ + dil_ * (Pq0_ + lrow)) * INW + 1024 + 64 * hd + 8 * lch; \
        _Pragma("unroll") for (int _s = 0; _s < 4; ++_s) dst[_s] = *(const u32x4*)(_qp + (size_t)(8 * _s * dil_) * INW); } while (0)
#define AT_QFRAGS() do { asm volatile("" ::: "memory"); _Pragma("unroll") for (int _s = 0; _s < 4; ++_s) *(LAS u32x4*)(Kimg + wo[_s]) = qn[_s]; asm volatile("" ::: "memory"); \
        _Pragma("unroll") for (int _s = 0; _s < 4; ++_s) qf[_s] = *(const LAS bf16x8*)(Kimg + kro + 16 * (_s ^ krx)); asm volatile("" ::: "memory"); } while (0)
    { AT_DESC(0, l0, d0, r0, q0, P0_, j0); (void)l0; (void)q0;
      AT_LOADQ(qn, r0, d0, P0_); AT_LOADX(r0, d0, P0_, j0, 0, 0); AT_LOADX(r0, d0, P0_, j0, 1, 1); AT_LOADX(r0, d0, P0_, j0, 2, 2); }
    for (int t = 0; t < 6; ++t) {
        {
            const int br = t >> 1;
            AT_DESC(t, ldil, dil, res, qtl, Pq0, jmin);
            const int tn = (t < 5) ? t + 1 : 5;
            AT_DESC(tn, ldiln, diln, resn, qtln, Pq0n, jminn); (void)ldiln; (void)qtln;
            AT_QFRAGS();
            f32x16 o0, o1;
#pragma unroll
            for (int i = 0; i < 16; ++i) { o0[i] = 0.f; o1[i] = 0.f; }
            float m = -INFINITY, lsum = 0.f;
#pragma unroll
            for (int j = 0; j < 5; ++j) {
                const int bi = j % 3;
                if (j >= jmin) {
                    asm volatile("" ::: "memory");
#pragma unroll
                    for (int s = 0; s < 4; ++s) { *(LAS u32x4*)(Kimg + wo[s]) = kf[bi][s]; *(LAS u32x4*)(Vimg + wo[s]) = vr[bi][s]; }
                    asm volatile("" ::: "memory");
                    bf16x8 kfr[4];
#pragma unroll
                    for (int s = 0; s < 4; ++s) kfr[s] = *(const LAS bf16x8*)(Kimg + kro + 16 * (s ^ krx));
                    f32x16 sc;
#pragma unroll
                    for (int i = 0; i < 16; ++i) sc[i] = 0.f;
#pragma unroll
                    for (int s = 0; s < 4; ++s) sc = MFMA32(kfr[s], qf[s], sc);
                    if (j == 0) {
#pragma unroll
                        for (int i = 0; i < 16; ++i) { const int kk = 8 * (i >> 2) + 4 * h + (i & 3); if (kk < r) sc[i] = -INFINITY; }
                    }
                    if (j == 4) {
#pragma unroll
                        for (int i = 0; i < 16; ++i) { const int kk = 8 * (i >> 2) + 4 * h + (i & 3); if (kk > r) sc[i] = -INFINITY; }
                    }
                    float tmax = sc[0];
#pragma unroll
                    for (int i = 1; i < 16; ++i) tmax = fmaxf(tmax, sc[i]);
                    tmax = fmaxf(tmax, xshfl(tmax, 32));
                    const float mnew = fmaxf(m, tmax), alpha = fast_exp2(m - mnew);
                    m = mnew;
                    float psum = 0.f;
#pragma unroll
                    for (int i = 0; i < 16; ++i) { sc[i] = fast_exp2(sc[i] - mnew); psum += sc[i]; }
                    lsum = lsum * alpha + psum;
#pragma unroll
                    for (int i = 0; i < 16; ++i) { o0[i] *= alpha; o1[i] *= alpha; }
                    const bf16x8 pb0 = pack8(sc, 0), pb1 = pack8(sc, 1);
#pragma unroll
                    for (int s2 = 0; s2 < 2; ++s2) {
#pragma unroll
                        for (int dt = 0; dt < 2; ++dt) {
                            const s16x4 lo = __builtin_amdgcn_ds_read_tr16_b64_v4i16((LAS s16x4*)(Vimg + trb[0][dt] + 2048 * s2));
                            const s16x4 hi = __builtin_amdgcn_ds_read_tr16_b64_v4i16((LAS s16x4*)(Vimg + trb[1][dt] + 2048 * s2));
                            const bf16x8 vf = __builtin_shufflevector(lo, hi, 0, 1, 2, 3, 4, 5, 6, 7);
                            if (dt == 0) o0 = MFMA32(vf, s2 ? pb1 : pb0, o0); else o1 = MFMA32(vf, s2 ? pb1 : pb0, o1);
                        }
                    }
                    asm volatile("" ::: "memory");
                }
                if (j + 3 < 5) AT_LOADX(res, dil, Pq0, jmin, j + 3, bi);
                else { if (j == 2) AT_LOADQ(qn, resn, diln, Pq0n); AT_LOADX(resn, diln, Pq0n, jminn, bi, bi); }
            }
            const float ltot = lsum + xshfl(lsum, 32);
            float lse = m + __builtin_amdgcn_logf(ltot);
            float fn = fast_rcp(ltot), fp = 0.f;
            const int tl = res + dil * (32 * qtl + r);
            LAS unsigned char* orow = Ost + tl * AT_OPITCH + 8 * h;
            if (br > 0) {
                const float lp = Lse[tl], mx = fmaxf(lp, lse), wp = fast_exp2(lp - mx), wn = fast_exp2(lse - mx), den = wp + wn, iden = fast_rcp(den);
                fp = wp * iden; fn = fn * wn * iden; lse = mx + __builtin_amdgcn_logf(den);
            }
            if (br < 2) { if (h == 0) Lse[tl] = lse; }
            bf16_t* grow = mixed + ((size_t)b * SEQ + sp * 512 + tl) * DM + 512 + 64 * hd + 4 * h;
#pragma unroll
            for (int dt = 0; dt < 2; ++dt)
#pragma unroll
                for (int g = 0; g < 4; ++g) {
                    float v0 = (dt ? o1 : o0)[4 * g] * fn, v1 = (dt ? o1 : o0)[4 * g + 1] * fn, v2 = (dt ? o1 : o0)[4 * g + 2] * fn, v3 = (dt ? o1 : o0)[4 * g + 3] * fn;
                    if (br > 0) { const u32x2 pw = *(const LAS u32x2*)(orow + 64 * dt + 16 * g);
                        v0 += fp * __uint_as_float(pw.x << 16); v1 += fp * __uint_as_float(pw.x & 0xffff0000u); v2 += fp * __uint_as_float(pw.y << 16); v3 += fp * __uint_as_float(pw.y & 0xffff0000u); }
                    u32x2 w; w.x = cvt_pk_bf16(v0, v1); w.y = cvt_pk_bf16(v2, v3);
                    if (br < 2) *(LAS u32x2*)(orow + 64 * dt + 16 * g) = w; else *(u32x2*)(grow + 32 * dt + 8 * g) = w;
                }
        }
        if (t & 1) __syncthreads();
    }
#undef AT_DESC
#undef AT_LOADX
#undef AT_LOADQ
#undef AT_QFRAGS
}


#define XB_TMO      128
#define XB_XCNT(j)  (256  + 64 * (j))
#define XB_XSUB(j)  (1280 + 64 * (j))
#define XB_XGEN(j)  (2304 + 64 * (j))
#define XB_TOP      3328
#define XB_TOPGEN   3392
#define XCD_BAR_WORDS 3456
#define XB_SPIN_CAP (1u << 20)
DI unsigned xb_ld(unsigned* p)              { return __hip_atomic_load(p, __ATOMIC_RELAXED, __HIP_MEMORY_SCOPE_AGENT); }
DI unsigned xb_add(unsigned* p, unsigned v) { return __hip_atomic_fetch_add(p, v, __ATOMIC_RELAXED, __HIP_MEMORY_SCOPE_AGENT); }
DI unsigned xb_xcc_id() { return (unsigned)__builtin_amdgcn_s_getreg((3 << 11) | 20) & 0xFu; }
#define XB_SPIN(cond, bar) do { unsigned _sp = 0; while (cond) { __builtin_amdgcn_s_sleep(1); \
    if ((++_sp & 255u) == 0u) { if (xb_ld(&(bar)[XB_TMO])) break; if (_sp > XB_SPIN_CAP) { atomicAdd(&(bar)[XB_TMO], 1u); break; } } } } while (0)
struct XcdBarrier { unsigned* bar; unsigned x; volatile LAS unsigned* st; };
DI XcdBarrier xcd_barrier_post(unsigned* bar, volatile LAS unsigned* st) {
    XcdBarrier b; b.bar = bar; b.x = xb_xcc_id(); b.st = st;
    if (threadIdx.x == 0) (void)xb_add(&bar[XB_XCNT(b.x)], 1u);
    return b;
}
DI void xcd_barrier_complete(unsigned* bar, unsigned x, unsigned& nloc, unsigned& nx) {
    const unsigned G = gridDim.x * gridDim.y * gridDim.z;
    unsigned sum, cnt, mine, sp = 0u;
    for (;;) {
        sum = 0u; cnt = 0u; mine = 0u;
#pragma unroll
        for (unsigned j = 0; j < 16; ++j) { const unsigned c = xb_ld(&bar[XB_XCNT(j)]); sum += c; cnt += (c > 0u) ? 1u : 0u; mine = (j == x) ? c : mine; }
        if (sum == G) break;
        __builtin_amdgcn_s_sleep(1);
        if ((++sp & 255u) == 0u) { if (xb_ld(&bar[XB_TMO])) break; if (sp > XB_SPIN_CAP) { atomicAdd(&bar[XB_TMO], 1u); break; } }
    }
    nloc = mine > 0u ? mine : 1u; nx = cnt > 0u ? cnt : 1u;
}
DI void xcd_barrier(const XcdBarrier& b0, int tid) {
    asm volatile("s_waitcnt vmcnt(0)" ::: "memory");
    __syncthreads();
    if (tid == 0) {
        XcdBarrier b; b.bar = launder_p(b0.bar); b.x = xb_xcc_id(); b.st = b0.st;
        unsigned* bar = b.bar;
        __builtin_amdgcn_s_waitcnt(0);
        unsigned nloc = b.st[0], nx = b.st[1];
        if (nloc == 0u) { xcd_barrier_complete(bar, b.x, nloc, nx); b.st[0] = nloc; b.st[1] = nx; }
        const unsigned old = xb_add(&bar[XB_XSUB(b.x)], 1u);
        const unsigned gen = old / nloc;
        if (old + 1u == (gen + 1u) * nloc) {
            __builtin_amdgcn_fence(__ATOMIC_RELEASE, "agent");
            asm volatile("s_waitcnt vmcnt(0)" ::: "memory");
            const unsigned og = xb_add(&bar[XB_TOP], 1u);
            const unsigned tg = og / nx;
            if (og + 1u == (tg + 1u) * nx) xb_add(&bar[XB_TOPGEN], 1u);
            else XB_SPIN(xb_ld(&bar[XB_TOPGEN]) == tg, bar);
            __builtin_amdgcn_fence(__ATOMIC_ACQUIRE, "agent");
            xb_add(&bar[XB_XGEN(b.x)], 1u);
            asm volatile("s_waitcnt vmcnt(0)" ::: "memory");
        } else {
            XB_SPIN(xb_ld(&bar[XB_XGEN(b.x)]) == gen, bar);
            __builtin_amdgcn_fence(__ATOMIC_ACQUIRE, "agent");
            asm volatile("s_waitcnt vmcnt(0)" ::: "memory");
        }
    }
    __syncthreads();
}

__global__ void __launch_bounds__(NTHR, 2) fwd_megakernel(Params p) {
    extern __shared__ __attribute__((aligned(16))) unsigned char smem[];
    LAS unsigned char* lds = (LAS unsigned char*)smem;
    cg::grid_group grid = cg::this_grid();
    const int tid0 = threadIdx.x;
    const int wave_s = __builtin_amdgcn_readfirstlane(tid0 >> 6);
#define TID() fresh_tid(wave_s)
    unsigned char* ws = p.ws;
    volatile LAS unsigned* bst = (volatile LAS unsigned*)(lds + LDS_BARW);
    if (tid0 < 4) bst[tid0] = 0u;
    __syncthreads();
    const XcdBarrier xbar = xcd_barrier_post((unsigned*)(ws + WS_BAR), bst);

    prelude_phase(p, lds, tid0);
    if (gridDim.x == 0x7fffffffu) grid.sync();
    xcd_barrier(xbar, TID());
    norm0_phase(p.x, p.norm_g, (const float*)(ws + WS_MOD) + DM, (bf16_t*)(ws + WS_Y), (float*)(ws + WS_SSQ), (bf16_t*)(ws + WS_H), TID());
    bias_phase(ws, TID());
    xcd_barrier(xbar, TID());

    for (int l = 0; l < 2; ++l) {
        for (int sb = 0; sb < 3; ++sb) {
            ws = launder_p(ws);
            const float* mod = (const float*)(ws + WS_MOD);
            const float* modl = mod + (size_t)l * 8 * (NADA * DM);
            bf16_t* Y = (bf16_t*)(ws + WS_Y); bf16_t* PG = (bf16_t*)(ws + WS_PG);
            const int slot = l * 3 + sb;
            float* ssq = (float*)(ws + WS_SSQ);
            bf16_t* H = (bf16_t*)(ws + WS_H);
            const bf16_t* A2; const bf16_t* B2; int K2; float gsc;
            if (sb != 1) {
                const int lf = l * 2 + (sb >> 1);
                pg8::Gemm g{Y, (const bf16_t*)(ws + WS_UP + (size_t)lf * SZ_UP), MTOK, 2 * FF, DM};
                pg8::StaticOrder S; S.init(MTOK, 2 * FF, (int)gridDim.x, (int)blockIdx.x);
                EpiSwiglu E{PG, ssq + (size_t)slot * MTOK, (const float*)(ws + WS_BUP) + (size_t)lf * 8 * (2 * FF)};
                pg8::gemm_phase<EpiSwiglu>(lds, g, S, E, TID());
                xcd_barrier(xbar, TID());
                A2 = PG; B2 = (const bf16_t*)(ws + WS_DN + (size_t)lf * SZ_DN); K2 = FF; gsc = 0.5f;
            } else {
                pg8::Gemm g{Y, (const bf16_t*)(ws + WS_IN + (size_t)l * SZ_IN), MTOK, INW, DM};
                pg8::StaticOrder S; S.init(MTOK, INW, (int)gridDim.x, (int)blockIdx.x);
                EpiIn E{PG, (const float*)(ws + WS_ROPE), ssq + (size_t)slot * MTOK, (const float*)(ws + WS_BIN) + (size_t)l * 8 * INW};
                pg8::gemm_phase<EpiIn>(lds, g, S, E, TID());
                xcd_barrier(xbar, TID());
                for (int it = blockIdx.x; it < 1024; it += gridDim.x) sgu_item(p, l, it, lds, TID());
                for (int it = blockIdx.x; it < 512; it += gridDim.x) attn_item(p, it, lds, TID());
                xcd_barrier(xbar, TID());
                A2 = (const bf16_t*)(ws + WS_MIX); B2 = (const bf16_t*)(ws + WS_OUT + (size_t)l * SZ_OUT); K2 = DM; gsc = 1.0f;
            }
            {
                const int ns = slot + 1, nl = ns / 3, nsb = ns % 3;
                pg8::Gemm g{A2, B2, MTOK, DM, K2};
                pg8::StaticOrder S; S.init(MTOK, DM, (int)gridDim.x, (int)blockIdx.x);
                EpiResid E{H, H, modl + (3 * sb + 2) * DM, (ns < 6) ? Y : (bf16_t*)nullptr, ssq + (size_t)ns * MTOK,
                           p.norm_g + (size_t)(ns < 6 ? ns : 0) * DM, mod + (size_t)(ns < 6 ? nl : 0) * 8 * (NADA * DM) + (3 * nsb + 1) * DM, gsc, 0.f};
                pg8::gemm_phase<EpiResid>(lds, g, S, E, TID());
                xcd_barrier(xbar, TID());
            }
        }
    }
    ws = launder_p(ws);
    final_norm_phase((const bf16_t*)(ws + WS_H), p.out, p.final_g, (const float*)(ws + WS_SSQ) + (size_t)6 * MTOK, TID());
}

constexpr int LDS_BYTES = LDS_BARW + 16;
static_assert(LDS_BARW >= 131072 && LDS_BYTES <= 160 * 1024, "LDS map");
extern "C" void kernel_launch(void* const* d_in, const int* in_sizes, int n_in, void* d_out, int out_size, void* d_ws, size_t ws_size, hipStream_t stream) {
    static int grid_blocks = 0;
    if (!grid_blocks) {
        int dev = 0, cus = 0, per_cu = 0;
        hipGetDevice(&dev);
        hipDeviceGetAttribute(&cus, hipDeviceAttributeMultiprocessorCount, dev);
        hipFuncSetAttribute((const void*)fwd_megakernel, hipFuncAttributeMaxDynamicSharedMemorySize, LDS_BYTES);
        hipOccupancyMaxActiveBlocksPerMultiprocessor(&per_cu, (const void*)fwd_megakernel, NTHR, LDS_BYTES);
        if (per_cu < 1) per_cu = 1;
        grid_blocks = cus * per_cu;
        if (ws_size < WS_END) fprintf(stderr, "kernel_launch: workspace too small (%zu < %zu)\n", ws_size, (size_t)WS_END);
    }
    Params p{};
    p.x = (const float*)d_in[0]; p.c = (const float*)d_in[1]; p.ada_w = (const float*)d_in[2]; p.ada_b = (const float*)d_in[3]; p.norm_g = (const float*)d_in[4];
    p.f1g = (const float*)d_in[5]; p.f1u = (const float*)d_in[6]; p.f1d = (const float*)d_in[7]; p.f2g = (const float*)d_in[8]; p.f2u = (const float*)d_in[9]; p.f2d = (const float*)d_in[10];
    p.w_in = (const float*)d_in[11]; p.sgu_ln_g = (const float*)d_in[12]; p.sgu_ln_b = (const float*)d_in[13]; p.sgu_w = (const float*)d_in[14]; p.sgu_b = (const float*)d_in[15];
    p.w_out = (const float*)d_in[16]; p.final_g = (const float*)d_in[17];
    p.out = (float*)d_out; p.ws = (unsigned char*)d_ws;
    (void)hipMemsetAsync((unsigned char*)d_ws + WS_BAR, 0, ZERO_BYTES, stream);
    void* args[] = {&p};
    hipError_t e = hipLaunchCooperativeKernel((const void*)fwd_megakernel, dim3(grid_blocks), dim3(NTHR), args, LDS_BYTES, stream);
    if (e != hipSuccess) fprintf(stderr, "cooperative launch failed: %s (grid %d)\n", hipGetErrorString(e), grid_blocks);
}
```

```cpp
#include <hip/hip_runtime.h>
#include <hip/hip_cooperative_groups.h>
#include <cstdio>
namespace cg = cooperative_groups;

#define LAS __attribute__((address_space(3)))
#define DI __device__ __forceinline__
typedef unsigned short bf16_t;
typedef short bf16x8 __attribute__((ext_vector_type(8)));
typedef short s16x4 __attribute__((ext_vector_type(4)));
typedef float f32x4 __attribute__((ext_vector_type(4)));
typedef float f32x2 __attribute__((ext_vector_type(2)));
typedef float f32x16 __attribute__((ext_vector_type(16)));
typedef unsigned u32x4 __attribute__((ext_vector_type(4)));
typedef unsigned u32x2 __attribute__((ext_vector_type(2)));

constexpr int DM = 1024, NB = 8, SEQ = 4096, MTOK = NB * SEQ, FF = 2816, INW = 2560, NADA = 9;
constexpr int NTHR = 512;
constexpr float EPS = 1e-6f;

constexpr size_t SZ_UP = (size_t)2 * FF * DM * 2;
constexpr size_t SZ_DN = (size_t)DM * FF * 2;
constexpr size_t SZ_IN = (size_t)INW * DM * 2;
constexpr size_t SZ_OUT = (size_t)DM * DM * 2;
constexpr size_t WS_UP = 0;
constexpr size_t WS_DN = WS_UP + 4 * SZ_UP;
constexpr size_t WS_IN = WS_DN + 4 * SZ_DN;
constexpr size_t WS_OUT = WS_IN + 2 * SZ_IN;
constexpr size_t WS_SGUW = WS_OUT + 2 * SZ_OUT;
constexpr size_t WS_MOD = WS_SGUW + (size_t)2 * 4 * 128 * 128 * 2;
constexpr size_t WS_ROPE = WS_MOD + (size_t)2 * 8 * 9216 * 4;
constexpr size_t WS_Y = WS_ROPE + (size_t)4096 * 32 * 8;
constexpr size_t WS_PG = WS_Y + (size_t)MTOK * DM * 2;
constexpr size_t WS_MIX = WS_PG + (size_t)MTOK * FF * 2;
constexpr size_t WS_H = WS_MIX + (size_t)MTOK * DM * 2;
constexpr size_t WS_BUP = WS_H + (size_t)MTOK * DM * 2;
constexpr size_t WS_BIN = WS_BUP + (size_t)4 * 8 * 2 * FF * 4;
constexpr size_t WS_BAR = WS_BIN + (size_t)2 * 8 * INW * 4;
constexpr size_t WS_SSQ = WS_BAR + 16384;
constexpr size_t ZERO_BYTES = 16384 + (size_t)7 * MTOK * 4;
constexpr size_t WS_END = WS_BAR + ZERO_BYTES;

struct Params {
    const float *x, *c, *ada_w, *ada_b, *norm_g, *f1g, *f1u, *f1d, *f2g, *f2u, *f2d, *w_in, *sgu_ln_g, *sgu_ln_b, *sgu_w, *sgu_b, *w_out, *final_g;
    float* out; unsigned char* ws;
};

DI int launder_v(int x) { asm volatile("" : "+v"(x)); return x; }
template <class T> DI T* launder_p(T* q) { size_t z = 0; asm volatile("" : "+s"(z)); return (T*)((unsigned char*)q + z); }
DI int fresh_lane() { unsigned z = 0; asm volatile("" : "+s"(z)); return (int)__builtin_amdgcn_mbcnt_hi(~0u, __builtin_amdgcn_mbcnt_lo(~0u, z)); }
DI int fresh_tid(int wave_s) { asm volatile("" : "+s"(wave_s)); return wave_s * 64 + fresh_lane(); }
DI float xshfl(float v, int mask) { const int idx = (fresh_lane() ^ mask) << 2; return __int_as_float(__builtin_amdgcn_ds_bpermute(idx, __float_as_int(v))); }
DI float sum_xor16(float v) { const auto a = __builtin_amdgcn_permlane16_swap(__float_as_uint(v), __float_as_uint(v), false, false); return __uint_as_float(a[0]) + __uint_as_float(a[1]); }
DI float sum_xor32(float v) { const auto a = __builtin_amdgcn_permlane32_swap(__float_as_uint(v), __float_as_uint(v), false, false); return __uint_as_float(a[0]) + __uint_as_float(a[1]); }
DI float max_xor32(float v) { const auto a = __builtin_amdgcn_permlane32_swap(__float_as_uint(v), __float_as_uint(v), false, false); return fmaxf(__uint_as_float(a[0]), __uint_as_float(a[1])); }
DI float bf2f(unsigned short v) { return __uint_as_float((unsigned)v << 16); }
DI unsigned short f2bf(float f) { unsigned u = __float_as_uint(f); u += 0x7fffu + ((u >> 16) & 1u); return (unsigned short)(u >> 16); }
DI unsigned cvt_pk_bf16(float lo, float hi) { unsigned r; asm("v_cvt_pk_bf16_f32 %0, %1, %2" : "=v"(r) : "v"(lo), "v"(hi)); return r; }
DI float fast_exp2(float x) { return __builtin_amdgcn_exp2f(x); }
DI float fast_rcp(float x) { return __builtin_amdgcn_rcpf(x); }
DI float silu_f(float x) { return x * fast_rcp(1.0f + fast_exp2(-1.4426950409f * x)); }
DI float gelu_tanh_f(float x) { const float t = 0.7978845608f * (x + 0.044715f * x * x * x); return x * fast_rcp(1.0f + fast_exp2(-2.8853900818f * t)); }

namespace pg8 {
constexpr int BM = 256, BK = 64, HALF = 128, HTB = HALF * BK * 2, STAGE_BYTES = 8 * HTB, NXCD = 8, WGM = 8;
DI int lds_byte(int r, int c) { const int st = (r >> 4) * 2 + (c >> 5), rr = r & 15, cc = c & 31, ob = rr * 64 + cc * 2; return st * 1024 + (ob ^ (((ob >> 9) & 1) << 5)); }
DI void stage_rc(int b, int& R, int& C) { const int st = b / 1024, sb = b % 1024, swz = sb ^ (((sb >> 9) & 1) << 5); R = (st >> 1) * 16 + swz / 64; C = (st & 1) * 32 + (swz % 64) / 2; }
DI int perm32(int rho) { const int n = rho >> 4, i = rho & 15; return 8 * (i >> 2) + 4 * n + (i & 3); }
struct Unit { int pm, pn; };
struct Gemm { const bf16_t* A; const bf16_t* Bt; int M, N, K; };
struct StaticOrder {
    int nM, nN, nwg, G, c;
    DI void init(int M, int N, int G_, int c_) { nM = M / BM; nN = N / BM; nwg = nM * nN; G = G_; c = c_; }
    DI bool next(int i, Unit& u) const {
        const long L = (long)i * G + c; if (L >= nwg) return false;
        int wgid = (int)L; { const int q = nwg / NXCD, r = nwg % NXCD, xcd = wgid % NXCD, off = wgid / NXCD; wgid = (xcd < r ? xcd * (q + 1) : r * (q + 1) + (xcd - r) * q) + off; }
        const int nig = WGM * nN, gid = wgid / nig, fm = gid * WGM, gsz = (nM - fm) < WGM ? (nM - fm) : WGM;
        u.pm = fm + ((wgid % nig) % gsz); u.pn = (wgid % nig) / gsz; return true;
    }
};

template <class Epi>
DI void gemm_phase(LAS unsigned char* lds, const Gemm g, const StaticOrder& S, const Epi& E, int tid_in) {
    const int tid = launder_v(tid_in), wid = __builtin_amdgcn_readfirstlane(tid >> 6), lane = tid & 63, wr = wid >> 2, wc = wid & 3, fr = lane & 15, fq = lane >> 4;
    const int K = g.K, nt = K / BK;
    unsigned voffA[2], voffB[2];
#pragma unroll
    for (int i = 0; i < 2; ++i) { int R, C; stage_rc(tid * 16 + i * 8192, R, C); const int Rb = Epi::PERM ? ((R & ~31) + perm32(R & 31)) : R;
        voffA[i] = (unsigned)(R * K + C) * 2u; voffB[i] = (unsigned)(Rb * K + C) * 2u; }
    const size_t kstep = (size_t)(BK * 2);
    const size_t hstep = (size_t)HALF * K * 2;
    const size_t tstep = 2 * hstep;
    const unsigned ldsw = (unsigned)wid * 1024u;
    const int aoff = lds_byte(wr * 64 + fr, fq * 8), boff = lds_byte(wc * 32 + fr, fq * 8);
#define PG8_SA(b, h) (((b) * 2 + (h)) * HTB)
#define PG8_SB(b, h) ((4 + (b) * 2 + (h)) * HTB)
#define PG8_STAGE(bufoff, gbase, voff) do { _Pragma("unroll") for (int _i = 0; _i < 2; ++_i) \
        __builtin_amdgcn_global_load_lds((const unsigned*)((const char*)(gbase) + (voff)[_i]), (LAS unsigned*)(lds + (bufoff) + ldsw + _i * 8192), 16, 0, 0); } while (0)
#define PG8_LDA(dst, b, h) do { _Pragma("unroll") for (int m = 0; m < 4; ++m) _Pragma("unroll") for (int k = 0; k < 2; ++k) dst[m][k] = *(const LAS bf16x8*)(lds + PG8_SA(b, h) + aoff + m * 2048 + k * 1024); } while (0)
#define PG8_LDB(dst, b, h) do { _Pragma("unroll") for (int n = 0; n < 2; ++n) _Pragma("unroll") for (int k = 0; k < 2; ++k) dst[n][k] = *(const LAS bf16x8*)(lds + PG8_SB(b, h) + boff + n * 2048 + k * 1024); } while (0)
#define PG8_MMA(ai, bj, At, Bt) do { __builtin_amdgcn_s_setprio(1); _Pragma("unroll") for (int m = 0; m < 4; ++m) _Pragma("unroll") for (int n = 0; n < 2; ++n) _Pragma("unroll") for (int k = 0; k < 2; ++k) \
        acc[ai][bj][m][n] = __builtin_amdgcn_mfma_f32_16x16x32_bf16(Bt[n][k], At[m][k], acc[ai][bj][m][n], 0, 0, 0); __builtin_amdgcn_s_setprio(0); } while (0)
#define PG8_WAIT_V(n) asm volatile("s_waitcnt vmcnt(" #n ")" ::: "memory")
#define PG8_WAIT_L(n) asm volatile("s_waitcnt lgkmcnt(" #n ")" ::: "memory")
#define PG8_BAR __builtin_amdgcn_s_barrier()
#define PG8_SCHED __builtin_amdgcn_sched_barrier(0)
    Unit cur, nxt; int ui = 0;
    if (!S.next(0, cur)) return;
    f32x4 acc[2][2][4][2];
#pragma unroll
    for (int a = 0; a < 2; ++a)
#pragma unroll
        for (int b = 0; b < 2; ++b)
#pragma unroll
            for (int m = 0; m < 4; ++m)
#pragma unroll
                for (int n = 0; n < 2; ++n) acc[a][b][m][n] = (f32x4){0.f, 0.f, 0.f, 0.f};
    bf16x8 At[4][2], B0[2][2], B1[2][2];
    const char* cA = (const char*)g.A + (size_t)cur.pm * tstep; const char* cB = (const char*)g.Bt + (size_t)cur.pn * tstep;
    PG8_STAGE(PG8_SB(0, 0), cB, voffB); PG8_STAGE(PG8_SA(0, 0), cA, voffA); PG8_STAGE(PG8_SB(0, 1), cB + hstep, voffB); PG8_STAGE(PG8_SA(0, 1), cA + hstep, voffA);
    if (wr == 1) PG8_BAR;
    PG8_WAIT_V(4); PG8_BAR;
    PG8_STAGE(PG8_SB(1, 0), cB + kstep, voffB); PG8_STAGE(PG8_SA(1, 0), cA + kstep, voffA); PG8_STAGE(PG8_SB(1, 1), cB + hstep + kstep, voffB);
    PG8_WAIT_V(6); PG8_BAR;
    for (;;) {
        const bool has_next = S.next(ui + 1, nxt);
        const char* nA = has_next ? (const char*)g.A + (size_t)nxt.pm * tstep : cA; const char* nB = has_next ? (const char*)g.Bt + (size_t)nxt.pn * tstep : cB;
        for (int t = 0; t < nt; t += 2) {
            const bool last = (t == nt - 2);
            const char* a1 = cA + (size_t)(t + 1) * kstep;
            const char* a2 = last ? nA : cA + (size_t)(t + 2) * kstep; const char* b2 = last ? nB : cB + (size_t)(t + 2) * kstep;
            const char* a3 = a2 + kstep; const char* b3 = b2 + kstep;
            PG8_LDB(B0, 0, 0); PG8_SCHED; PG8_LDA(At, 0, 0); PG8_STAGE(PG8_SA(1, 1), a1 + hstep, voffA);
            PG8_WAIT_L(8); PG8_BAR; PG8_WAIT_L(0); PG8_MMA(0, 0, At, B0); PG8_BAR; PG8_SCHED;
            PG8_LDB(B1, 0, 1); PG8_STAGE(PG8_SB(0, 0), b2, voffB);
            PG8_BAR; PG8_WAIT_L(0); PG8_MMA(0, 1, At, B1); PG8_BAR;
            PG8_LDA(At, 0, 1); PG8_STAGE(PG8_SA(0, 0), a2, voffA);
            PG8_BAR; PG8_WAIT_L(0); PG8_MMA(1, 0, At, B0); PG8_BAR; PG8_SCHED;
            PG8_STAGE(PG8_SB(0, 1), b2 + hstep, voffB);
            PG8_WAIT_V(6); PG8_BAR; PG8_MMA(1, 1, At, B1); PG8_BAR;
            PG8_LDB(B0, 1, 0); PG8_SCHED; PG8_LDA(At, 1, 0); PG8_STAGE(PG8_SA(0, 1), a2 + hstep, voffA);
            PG8_WAIT_L(8); PG8_BAR; PG8_WAIT_L(0); PG8_MMA(0, 0, At, B0); PG8_BAR; PG8_SCHED;
            PG8_LDB(B1, 1, 1); PG8_STAGE(PG8_SB(1, 0), b3, voffB);
            PG8_BAR; PG8_WAIT_L(0); PG8_MMA(0, 1, At, B1); PG8_BAR;
            PG8_LDA(At, 1, 1); PG8_STAGE(PG8_SA(1, 0), a3, voffA);
            PG8_BAR; PG8_WAIT_L(0); PG8_MMA(1, 0, At, B0); PG8_BAR; PG8_SCHED;
            PG8_STAGE(PG8_SB(1, 1), b3 + hstep, voffB);
            PG8_WAIT_V(6); PG8_BAR; PG8_MMA(1, 1, At, B1); PG8_BAR;
        }
        E(acc, cur, wr, wc, fr, fq);
        if (!has_next) break;
#pragma unroll
        for (int a = 0; a < 2; ++a)
#pragma unroll
            for (int b = 0; b < 2; ++b)
#pragma unroll
                for (int m = 0; m < 4; ++m)
#pragma unroll
                    for (int n = 0; n < 2; ++n) acc[a][b][m][n] = (f32x4){0.f, 0.f, 0.f, 0.f};
        cur = nxt; cA = nA; cB = nB; ++ui;
    }
    PG8_WAIT_V(0);
    if (wr == 0) PG8_BAR;
    PG8_BAR;
#undef PG8_SA
#undef PG8_SB
#undef PG8_STAGE
#undef PG8_LDA
#undef PG8_LDB
#undef PG8_MMA
#undef PG8_WAIT_V
#undef PG8_WAIT_L
#undef PG8_BAR
#undef PG8_SCHED
}
}

struct EpiSwiglu {
    static constexpr bool PERM = true;
    bf16_t* G; const float* ssq; const float* bias;
    DI void operator()(const f32x4 (&acc)[2][2][4][2], const pg8::Unit& u, int wr, int wc, int fr, int fq) const {
        const int row0 = u.pm * 256 + wr * 64 + fr, col0 = u.pn * 128 + wc * 32 + 8 * fq, b = (u.pm * 256) / SEQ;
        const float* bp = bias + (size_t)b * (2 * FF) + u.pn * 256 + wc * 32 + 8 * fq;
        const f32x4 bg0 = *(const f32x4*)bp, bg1 = *(const f32x4*)(bp + 4), bu0 = *(const f32x4*)(bp + 128), bu1 = *(const f32x4*)(bp + 132);
        float sq[8];
#pragma unroll
        for (int i = 0; i < 8; ++i) sq[i] = ssq[row0 + (i >> 2) * 128 + (i & 3) * 16];
#pragma unroll
        for (int ai = 0; ai < 2; ++ai)
#pragma unroll
            for (int m = 0; m < 4; ++m) {
                bf16_t* rowp = G + (size_t)(row0 + ai * 128 + m * 16) * FF + col0;
                const float rstd = rsqrtf(sq[ai * 4 + m] * (1.0f / DM) + EPS);
                const f32x4 g0 = acc[ai][0][m][0] * rstd + bg0, g1 = acc[ai][0][m][1] * rstd + bg1, u0 = acc[ai][1][m][0] * rstd + bu0, u1 = acc[ai][1][m][1] * rstd + bu1;
                u32x4 w;
                w.x = cvt_pk_bf16(silu_f(g0[0]) * u0[0], silu_f(g0[1]) * u0[1]); w.y = cvt_pk_bf16(silu_f(g0[2]) * u0[2], silu_f(g0[3]) * u0[3]);
                w.z = cvt_pk_bf16(silu_f(g1[0]) * u1[0], silu_f(g1[1]) * u1[1]); w.w = cvt_pk_bf16(silu_f(g1[2]) * u1[2], silu_f(g1[3]) * u1[3]);
                *(u32x4*)rowp = w;
            }
    }
};
struct EpiResid {
    static constexpr bool PERM = true;
    const bf16_t* hin; bf16_t* hout; const float* gate;
    bf16_t* ynext; float* ssqn; const float* gnext; const float* scnext;
    float gscale, pad_;
    DI void operator()(const f32x4 (&acc)[2][2][4][2], const pg8::Unit& u, int wr, int wc, int fr, int fq) const {
        const int row0 = u.pm * 256 + wr * 64 + fr, col0 = u.pn * 256 + wc * 32 + 8 * fq, b = (u.pm * 256) / SEQ;
        const bool has_y = ynext != nullptr;
        float rs[8];
#pragma unroll
        for (int it = 0; it < 8; ++it) rs[it] = 0.f;
#pragma unroll
        for (int bj = 0; bj < 2; ++bj) {
            u32x4 hb[8];
#pragma unroll
            for (int it = 0; it < 8; ++it) hb[it] = *(const u32x4*)(hin + (size_t)(row0 + (it >> 2) * 128 + (it & 3) * 16) * DM + col0 + bj * 128);
            const float* gp = gate + (size_t)b * (NADA * DM) + col0 + bj * 128;
            const f32x4 gv0 = *(const f32x4*)gp * gscale, gv1 = *(const f32x4*)(gp + 4) * gscale;
            const float* np = gnext + col0 + bj * 128; const float* sp = scnext + (size_t)b * (NADA * DM) + col0 + bj * 128;
            const f32x4 gm0 = *(const f32x4*)np * (*(const f32x4*)sp + 1.0f), gm1 = *(const f32x4*)(np + 4) * (*(const f32x4*)(sp + 4) + 1.0f);
            __builtin_amdgcn_sched_barrier(0);
#pragma unroll
            for (int it = 0; it < 8; ++it) {
                const int ai = it >> 2, m = it & 3;
                const size_t off = (size_t)(row0 + ai * 128 + m * 16) * DM + col0 + bj * 128;
                const u32x4 q = hb[it];
                f32x4 h0 = {__uint_as_float(q.x << 16), __uint_as_float(q.x & 0xffff0000u), __uint_as_float(q.y << 16), __uint_as_float(q.y & 0xffff0000u)};
                f32x4 h1 = {__uint_as_float(q.z << 16), __uint_as_float(q.z & 0xffff0000u), __uint_as_float(q.w << 16), __uint_as_float(q.w & 0xffff0000u)};
                h0 += gv0 * acc[ai][bj][m][0]; h1 += gv1 * acc[ai][bj][m][1];
                rs[it] += h0[0] * h0[0] + h0[1] * h0[1] + h0[2] * h0[2] + h0[3] * h0[3] + h1[0] * h1[0] + h1[1] * h1[1] + h1[2] * h1[2] + h1[3] * h1[3];
                u32x4 wh; wh.x = cvt_pk_bf16(h0[0], h0[1]); wh.y = cvt_pk_bf16(h0[2], h0[3]); wh.z = cvt_pk_bf16(h1[0], h1[1]); wh.w = cvt_pk_bf16(h1[2], h1[3]);
                *(u32x4*)(hout + off) = wh;
                if (has_y) { const f32x4 a0 = h0 * gm0, a1 = h1 * gm1;
                    u32x4 wy; wy.x = cvt_pk_bf16(a0[0], a0[1]); wy.y = cvt_pk_bf16(a0[2], a0[3]); wy.z = cvt_pk_bf16(a1[0], a1[1]); wy.w = cvt_pk_bf16(a1[2], a1[3]);
                    *(u32x4*)(ynext + off) = wy; }
            }
            __builtin_amdgcn_sched_barrier(0);
        }
#pragma unroll
        for (int it = 0; it < 8; ++it) {
            float v = sum_xor32(sum_xor16(rs[it]));
            if (fq == 0) (void)__hip_atomic_fetch_add(ssqn + row0 + (it >> 2) * 128 + (it & 3) * 16, v, __ATOMIC_RELAXED, __HIP_MEMORY_SCOPE_AGENT);
        }
    }
};
struct EpiIn {
    static constexpr bool PERM = true;
    bf16_t* P; const float* rope; const float* ssq; const float* bias;
    DI void operator()(const f32x4 (&acc)[2][2][4][2], const pg8::Unit& u, int wr, int wc, int fr, int fq) const {
        const int row0 = u.pm * 256 + wr * 64 + fr, col0 = u.pn * 256 + wc * 32 + 8 * fq, kind = u.pn >> 1, b = (u.pm * 256) / SEQ;
        const int i0 = 16 * (wc & 1) + 4 * fq;
        const bool is_rope = (kind == 2 || kind == 3);
        const float* bp = bias + (size_t)b * INW + col0;
        const f32x4 bv00 = *(const f32x4*)bp, bv01 = *(const f32x4*)(bp + 4), bv10 = *(const f32x4*)(bp + 128), bv11 = *(const f32x4*)(bp + 132);
        float sq[8];
#pragma unroll
        for (int i = 0; i < 8; ++i) sq[i] = ssq[row0 + (i >> 2) * 128 + (i & 3) * 16];
        const float qs = (kind == 2) ? 0.125f * 1.4426950409f : 1.0f;
        f32x4 cs0 = {1.f, 0.f, 1.f, 0.f}, cs1 = {1.f, 0.f, 1.f, 0.f};
        if (is_rope) { const f32x4* rp = (const f32x4*)(rope + ((size_t)(row0 & (SEQ - 1)) * 32 + i0) * 2); cs0 = rp[0]; cs1 = rp[1]; }
#pragma unroll
        for (int it = 0; it < 8; ++it) {
            const int ai = it >> 2, m = it & 3;
            const int row = row0 + ai * 128 + m * 16;
            bf16_t* rowp = P + (size_t)row * INW + col0;
            const float rstd = rsqrtf(sq[it] * (1.0f / DM) + EPS);
            f32x4 cn0 = cs0, cn1 = cs1;
            if (is_rope && it < 7) { const int row2 = row0 + ((it + 1) >> 2) * 128 + ((it + 1) & 3) * 16;
                const f32x4* rp = (const f32x4*)(rope + ((size_t)(row2 & (SEQ - 1)) * 32 + i0) * 2); cn0 = rp[0]; cn1 = rp[1]; }
            __builtin_amdgcn_sched_barrier(0);
#pragma unroll
            for (int bj = 0; bj < 2; ++bj) {
                f32x4 v0 = acc[ai][bj][m][0] * rstd + (bj ? bv10 : bv00), v1 = acc[ai][bj][m][1] * rstd + (bj ? bv11 : bv01);
                if (kind <= 1) {
#pragma unroll
                    for (int j = 0; j < 4; ++j) { v0[j] = gelu_tanh_f(v0[j]); v1[j] = gelu_tanh_f(v1[j]); }
                } else if (kind <= 3) {
#pragma unroll
                    for (int j = 0; j < 4; ++j) { const float cj = (j < 2 ? cs0 : cs1)[(j & 1) * 2], sj = (j < 2 ? cs0 : cs1)[(j & 1) * 2 + 1];
                        const float x1 = v0[j], x2 = v1[j]; v0[j] = (x1 * cj - x2 * sj) * qs; v1[j] = (x2 * cj + x1 * sj) * qs; }
                }
                u32x4 w; w.x = cvt_pk_bf16(v0[0], v0[1]); w.y = cvt_pk_bf16(v0[2], v0[3]); w.z = cvt_pk_bf16(v1[0], v1[1]); w.w = cvt_pk_bf16(v1[2], v1[3]);
                *(u32x4*)(rowp + bj * 128) = w;
            }
            cs0 = cn0; cs1 = cn1;
        }
    }
};

DI void tr_tile(const float* src, int ld_src, int srccol0, int k0, bf16_t* dst, int ld_dst, int n0, bool rperm, LAS float* tile, int tid) {
#pragma unroll
    for (int i = 0; i < 2; ++i) {
        const int idx = tid + i * NTHR, row = idx >> 4, c4 = idx & 15;
        const f32x4 v = *(const f32x4*)(src + (size_t)(k0 + row) * ld_src + srccol0 + c4 * 4);
        LAS float* t = tile + row * 65 + c4 * 4; t[0] = v[0]; t[1] = v[1]; t[2] = v[2]; t[3] = v[3];
    }
    __syncthreads();
    const int p = tid >> 3, kc = (tid & 7) * 8;
    const int pp = rperm ? (4 * (p >> 3) + (p & 3) + 32 * ((p >> 2) & 1)) : p;
    float v[8];
#pragma unroll
    for (int j = 0; j < 8; ++j) v[j] = tile[(kc + j) * 65 + pp];
    u32x4 w; w.x = cvt_pk_bf16(v[0], v[1]); w.y = cvt_pk_bf16(v[2], v[3]); w.z = cvt_pk_bf16(v[4], v[5]); w.w = cvt_pk_bf16(v[6], v[7]);
    *(u32x4*)(dst + (size_t)(n0 + p) * ld_dst + k0 + kc) = w;
    __syncthreads();
}

constexpr int IT_MOD = 288;
constexpr int IT_ROPE = 256, IT_SGUW = 256;
constexpr int T_UP = 88 * 16, T_DN = 16 * 44, T_IN = 40 * 16, T_OUT = 16 * 16;
constexpr int IT_UP0 = IT_MOD + IT_ROPE + IT_SGUW, IT_DN0 = IT_UP0 + 4 * T_UP, IT_IN0 = IT_DN0 + 4 * T_DN, IT_OUT0 = IT_IN0 + 2 * T_IN, IT_END = IT_OUT0 + 2 * T_OUT;

DI void prelude_phase(const Params& p, LAS unsigned char* lds, int tid) {
    unsigned char* ws = p.ws;
    for (int it = blockIdx.x; it < IT_END; it += gridDim.x) {
        if (it < IT_MOD) {
            const int l = it / 144, cb = it % 144;
            LAS float* s = (LAS float*)lds; LAS float* red = (LAS float*)(lds + 32768);
            for (int i = tid; i < NB * DM; i += NTHR) s[i] = silu_f(p.c[i]);
            __syncthreads();
            const int cp = tid & 31, kg = tid >> 5;
            float a[8][2];
#pragma unroll
            for (int b = 0; b < 8; ++b) { a[b][0] = 0.f; a[b][1] = 0.f; }
            const float* w = p.ada_w + (size_t)l * DM * (NADA * DM) + (size_t)(kg * 64) * (NADA * DM) + cb * 64 + cp * 2;
#pragma unroll 4
            for (int k = 0; k < 64; ++k) {
                const f32x2 wv = *(const f32x2*)(w + (size_t)k * (NADA * DM));
#pragma unroll
                for (int b = 0; b < 8; ++b) { const float sv = s[b * DM + kg * 64 + k]; a[b][0] += sv * wv.x; a[b][1] += sv * wv.y; }
            }
#pragma unroll
            for (int b = 0; b < 8; ++b) { red[(kg * 8 + b) * 64 + cp * 2] = a[b][0]; red[(kg * 8 + b) * 64 + cp * 2 + 1] = a[b][1]; }
            __syncthreads();
            { const int b = tid >> 6, col = tid & 63; float sum = 0.f;
#pragma unroll
              for (int g = 0; g < 16; ++g) sum += red[(g * 8 + b) * 64 + col];
              const int n = cb * 64 + col;
              ((float*)(ws + WS_MOD))[((size_t)l * 8 + b) * (NADA * DM) + n] = sum + p.ada_b[(size_t)l * (NADA * DM) + n]; }
            __syncthreads();
        } else if (it < IT_MOD + IT_ROPE) {
            const int idx = (it - IT_MOD) * NTHR + tid, pos = idx >> 5, i = idx & 31;
            const float inv = exp2f(-(float)i * (13.287712379549449f / 32.0f));
            const float ang = (float)pos * inv;
            const double rev = (double)ang * 0.15915494309189535;
            const float fr = (float)(rev - floor(rev));
            f32x2 cs; cs.x = __builtin_amdgcn_cosf(fr); cs.y = __builtin_amdgcn_sinf(fr);
            ((f32x2*)(ws + WS_ROPE))[idx] = cs;
        } else if (it < IT_UP0) {
            const int idx = (it - IT_MOD - IT_ROPE) * NTHR + tid, j = idx & 127, i = (idx >> 7) & 127;
            ((bf16_t*)(ws + WS_SGUW))[idx] = (j <= i) ? f2bf(p.sgu_w[idx]) : (bf16_t)0;
        } else if (it < IT_DN0) {
            const int r = it - IT_UP0, lf = r / T_UP, t = r % T_UP, nb = t >> 4, kb = t & 15, l = lf >> 1, f = lf & 1;
            const int n0 = nb * 64, tl = n0 >> 8, half = (n0 >> 7) & 1, j0 = n0 & 127;
            const float* src = (f ? (half ? p.f2u : p.f2g) : (half ? p.f1u : p.f1g)) + (size_t)l * DM * FF;
            tr_tile(src, FF, tl * 128 + j0, kb * 64, (bf16_t*)(ws + WS_UP + (size_t)lf * SZ_UP), DM, n0, false, (LAS float*)lds, tid);
        } else if (it < IT_IN0) {
            const int r = it - IT_DN0, lf = r / T_DN, t = r % T_DN, nb = t / 44, kb = t % 44, l = lf >> 1, f = lf & 1;
            const float* src = (f ? p.f2d : p.f1d) + (size_t)l * FF * DM;
            tr_tile(src, DM, nb * 64, kb * 64, (bf16_t*)(ws + WS_DN + (size_t)lf * SZ_DN), FF, nb * 64, false, (LAS float*)lds, tid);
        } else if (it < IT_OUT0) {
            const int r = it - IT_IN0, l = r / T_IN, t = r % T_IN, nb = t >> 4, kb = t & 15, n0 = nb * 64;
            tr_tile(p.w_in + (size_t)l * DM * INW, INW, n0, kb * 64, (bf16_t*)(ws + WS_IN + (size_t)l * SZ_IN), DM, n0, (n0 >= 1024 && n0 < 2048), (LAS float*)lds, tid);
        } else {
            const int r = it - IT_OUT0, l = r / T_OUT, t = r % T_OUT, nb = t >> 4, kb = t & 15;
            tr_tile(p.w_out + (size_t)l * DM * DM, DM, nb * 64, kb * 64, (bf16_t*)(ws + WS_OUT + (size_t)l * SZ_OUT), DM, nb * 64, false, (LAS float*)lds, tid);
        }
    }
}

DI float wave_sum(float v) {
    v = sum_xor16(sum_xor32(v));
#pragma unroll
    for (int o = 8; o >= 1; o >>= 1) v += xshfl(v, o);
    return v;
}
DI void norm0_phase(const float* h, const float* g, const float* sc, bf16_t* y, float* ssq, bf16_t* hb, int tid) {
    tid = launder_v(tid);
    const int wave = tid >> 6, lane = tid & 63;
    for (int row = blockIdx.x * 8 + wave; row < MTOK; row += gridDim.x * 8) {
        const int b = row / SEQ;
        const float* hp = h + (size_t)row * DM;
        f32x4 v[4]; float ss = 0.f;
#pragma unroll
        for (int i = 0; i < 4; ++i) { v[i] = *(const f32x4*)(hp + i * 256 + lane * 4); ss += v[i][0] * v[i][0] + v[i][1] * v[i][1] + v[i][2] * v[i][2] + v[i][3] * v[i][3]; }
        ss = wave_sum(ss);
        if (lane == 0) ssq[row] = ss;
#pragma unroll
        for (int i = 0; i < 4; ++i) {
            const int col = i * 256 + lane * 4;
            const f32x4 gv = *(const f32x4*)(g + col), sv = *(const f32x4*)(sc + (size_t)b * (NADA * DM) + col);
            const f32x4 o = v[i] * gv * (sv + 1.0f);
            u32x2 w; w.x = cvt_pk_bf16(o[0], o[1]); w.y = cvt_pk_bf16(o[2], o[3]);
            *(u32x2*)(y + (size_t)row * DM + col) = w;
            u32x2 wx; wx.x = cvt_pk_bf16(v[i][0], v[i][1]); wx.y = cvt_pk_bf16(v[i][2], v[i][3]);
            *(u32x2*)(hb + (size_t)row * DM + col) = wx;
        }
    }
}
DI void bias_phase(unsigned char* ws, int tid) {
    tid = launder_v(tid);
    const int wave = tid >> 6, lane = tid & 63;
    const float* mod = (const float*)(ws + WS_MOD);
    for (int ri = blockIdx.x * 8 + wave; ri < 4 * 2 * FF + 2 * INW; ri += gridDim.x * 8) {
        const bf16_t* bt; const float* sh; float* outp; int bstride;
        if (ri < 4 * 2 * FF) { const int lf = ri / (2 * FF), n = ri % (2 * FF), l = lf >> 1, sb = (lf & 1) * 2;
            bt = (const bf16_t*)(ws + WS_UP + (size_t)lf * SZ_UP) + (size_t)n * DM; sh = mod + (size_t)l * 8 * (NADA * DM) + (3 * sb) * DM;
            outp = (float*)(ws + WS_BUP) + (size_t)lf * 8 * (2 * FF) + n; bstride = 2 * FF;
        } else { const int r2 = ri - 4 * 2 * FF, l = r2 / INW, n = r2 % INW;
            bt = (const bf16_t*)(ws + WS_IN + (size_t)l * SZ_IN) + (size_t)n * DM; sh = mod + (size_t)l * 8 * (NADA * DM) + 3 * DM;
            outp = (float*)(ws + WS_BIN) + (size_t)l * 8 * INW + n; bstride = INW; }
        float w[16];
#pragma unroll
        for (int i = 0; i < 2; ++i) { const u32x4 q = *(const u32x4*)(bt + lane * 16 + 8 * i);
#pragma unroll
            for (int k = 0; k < 4; ++k) { w[8 * i + 2 * k] = __uint_as_float(q[k] << 16); w[8 * i + 2 * k + 1] = __uint_as_float(q[k] & 0xffff0000u); } }
        float res = 0.f;
#pragma unroll
        for (int b = 0; b < 8; ++b) {
            float d = 0.f;
#pragma unroll
            for (int i = 0; i < 4; ++i) { const f32x4 sv = *(const f32x4*)(sh + (size_t)b * (NADA * DM) + lane * 16 + 4 * i); d += sv[0] * w[4 * i] + sv[1] * w[4 * i + 1] + sv[2] * w[4 * i + 2] + sv[3] * w[4 * i + 3]; }
            d = wave_sum(d);
            res = (lane == b) ? d : res;
        }
        if (lane < 8) outp[(size_t)lane * bstride] = res;
    }
}
DI void final_norm_phase(const bf16_t* h, float* out, const float* g, const float* ssq, int tid) {
    tid = launder_v(tid);
    const int wave = tid >> 6, lane = tid & 63;
    for (int row = blockIdx.x * 8 + wave; row < MTOK; row += gridDim.x * 8) {
        const float rstd = rsqrtf(ssq[row] * (1.0f / DM) + EPS);
#pragma unroll
        for (int i = 0; i < 2; ++i) {
            const int col = i * 512 + lane * 8;
            const u32x4 q = *(const u32x4*)(h + (size_t)row * DM + col);
            const f32x4 g0 = *(const f32x4*)(g + col), g1 = *(const f32x4*)(g + col + 4);
            const f32x4 h0 = {__uint_as_float(q.x << 16), __uint_as_float(q.x & 0xffff0000u), __uint_as_float(q.y << 16), __uint_as_float(q.y & 0xffff0000u)};
            const f32x4 h1 = {__uint_as_float(q.z << 16), __uint_as_float(q.z & 0xffff0000u), __uint_as_float(q.w << 16), __uint_as_float(q.w & 0xffff0000u)};
            *(f32x4*)(out + (size_t)row * DM + col) = h0 * rstd * g0; *(f32x4*)(out + (size_t)row * DM + col + 4) = h1 * rstd * g1;
        }
    }
}

#define MFMA32(a, b, c) __builtin_amdgcn_mfma_f32_32x32x16_bf16((a), (b), (c), 0, 0, 0)
DI bf16x8 pack8(const f32x16& x, int s) {
    u32x4 p; p.x = cvt_pk_bf16(x[8 * s], x[8 * s + 1]); p.y = cvt_pk_bf16(x[8 * s + 2], x[8 * s + 3]); p.z = cvt_pk_bf16(x[8 * s + 4], x[8 * s + 5]); p.w = cvt_pk_bf16(x[8 * s + 6], x[8 * s + 7]);
    return __builtin_bit_cast(bf16x8, p);
}

DI void sgu_item(const Params& p, int l, int item, LAS unsigned char* lds, int tid) {
    tid = launder_v(tid); unsigned char* wsl = launder_p(p.ws);
    const bf16_t* P = (const bf16_t*)(wsl + WS_PG); bf16_t* mixed = (bf16_t*)(wsl + WS_MIX);
    const int b = item >> 7, rem = item & 127, chunk = rem >> 2, hh = rem & 3;
    const size_t T0 = (size_t)b * SEQ + chunk * 128;
    {
        const int j = tid >> 2, qd = tid & 3;
        const bf16_t* vp = P + (T0 + j) * INW + 512 + 128 * hh + 32 * qd;
        float v[32];
#pragma unroll
        for (int i = 0; i < 4; ++i) { const u32x4 w = *(const u32x4*)(vp + 8 * i);
#pragma unroll
            for (int k = 0; k < 4; ++k) { v[8 * i + 2 * k] = __uint_as_float(w[k] << 16); v[8 * i + 2 * k + 1] = __uint_as_float(w[k] & 0xffff0000u); } }
        float sum = 0.f;
#pragma unroll
        for (int i = 0; i < 32; ++i) sum += v[i];
        sum += xshfl(sum, 1); sum += xshfl(sum, 2);
        const float mu = sum * (1.0f / 128.0f);
        float sq = 0.f;
#pragma unroll
        for (int i = 0; i < 32; ++i) { const float d = v[i] - mu; sq += d * d; }
        sq += xshfl(sq, 1); sq += xshfl(sq, 2);
        const float rstd = rsqrtf(sq * (1.0f / 128.0f) + EPS);
        const float* lg = p.sgu_ln_g + ((size_t)l * 4 + hh) * 128 + 32 * qd; const float* lb = p.sgu_ln_b + ((size_t)l * 4 + hh) * 128 + 32 * qd;
#pragma unroll
        for (int i = 0; i < 32; ++i) { const float o = (v[i] - mu) * rstd * lg[i] + lb[i]; *(LAS bf16_t*)(lds + (32 * qd + i) * 272 + j * 2) = f2bf(o); }
    }
    __syncthreads();
    {
        const int wave = __builtin_amdgcn_readfirstlane(tid >> 6), lane = tid & 63, r = lane & 31, h = lane >> 5;
        const int c0 = 32 * (wave & 3);
        const bf16_t* Wsb = (const bf16_t*)(wsl + WS_SGUW) + ((size_t)l * 4 + hh) * 128 * 128;
#pragma unroll
        for (int q = 0; q < 2; ++q) {
            const int itile = (wave < 4) ? (q ? 3 : 0) : (q ? 2 : 1), i0 = 32 * itile;
            f32x16 acc;
#pragma unroll
            for (int i = 0; i < 16; ++i) acc[i] = 0.f;
            const bf16_t* wrow = Wsb + (size_t)(i0 + r) * 128 + 8 * h;
            const LAS unsigned char* arow = lds + (c0 + r) * 272 + 16 * h;
            const int nks = 2 * (itile + 1);
            bf16x8 wf[8];
#pragma unroll
            for (int ks = 0; ks < 8; ++ks) wf[ks] = *(const bf16x8*)(wrow + (ks < nks ? ks : 0) * 16);
            const float bs = p.sgu_b[((size_t)l * 4 + hh) * 128 + i0 + r];
            const size_t tok = T0 + i0 + r;
            u32x2 uwv[4];
#pragma unroll
            for (int g = 0; g < 4; ++g) uwv[g] = *(const u32x2*)(P + tok * INW + 128 * hh + c0 + 8 * g + 4 * h);
#pragma unroll
            for (int ks = 0; ks < 8; ++ks) if (ks < nks) {
                const bf16x8 af = *(const LAS bf16x8*)(arow + ks * 32);
                acc = MFMA32(af, wf[ks], acc);
            }
#pragma unroll
            for (int g = 0; g < 4; ++g) {
                const int c = c0 + 8 * g + 4 * h;
                const u32x2 uw = uwv[g];
                const float u0 = __uint_as_float(uw.x << 16), u1 = __uint_as_float(uw.x & 0xffff0000u), u2 = __uint_as_float(uw.y << 16), u3 = __uint_as_float(uw.y & 0xffff0000u);
                u32x2 w; w.x = cvt_pk_bf16(u0 * (acc[4 * g] + bs), u1 * (acc[4 * g + 1] + bs)); w.y = cvt_pk_bf16(u2 * (acc[4 * g + 2] + bs), u3 * (acc[4 * g + 3] + bs));
                *(u32x2*)(mixed + tok * DM + 128 * hh + c) = w;
            }
        }
    }
    __syncthreads();
}

constexpr int AT_OPITCH = 136, AT_LSE_OFF = 512 * AT_OPITCH, AT_V_OFF = AT_LSE_OFF + 2048, AT_WBYTES = 8192;
constexpr int LDS_BARW = AT_V_OFF + 8 * AT_WBYTES;
DI void attn_item(const Params& p, int item, LAS unsigned char* lds, int tid) {
    tid = launder_v(tid); unsigned char* wsl = launder_p(p.ws);
    const bf16_t* P = (const bf16_t*)(wsl + WS_PG); bf16_t* mixed = (bf16_t*)(wsl + WS_MIX);
    const int wave = __builtin_amdgcn_readfirstlane(tid >> 6), lane = tid & 63, r = lane & 31, h = lane >> 5;
    const int xcd = item & 7, li = item >> 3, bh = (li >> 3) * 8 + xcd, sp = li & 7, b = bh >> 3, hd = bh & 7;
    const bf16_t* Pb = P + (size_t)b * SEQ * INW;
    LAS unsigned char* Ost = lds; LAS float* Lse = (LAS float*)(lds + AT_LSE_OFF);
    LAS unsigned char* Kimg = lds + AT_V_OFF + wave * AT_WBYTES; LAS unsigned char* Vimg = Kimg + 4096;
    const int lrow = lane >> 3, lch = lane & 7;
    int wo[4];
#pragma unroll
    for (int s = 0; s < 4; ++s) wo[s] = (8 * s + lrow) * 128 + 16 * (lch ^ ((((lrow >> 1) & 1) << 2) | ((2 * s + (lrow >> 2)) & 3)));
    const int kro = 128 * r + 64 * (h ^ ((r >> 1) & 1)), krx = (r >> 2) & 3;
    const int trq = (lane >> 2) & 3, trp = lane & 3, dhalf = (lane >> 4) & 1;
    int trb[2][2];
#pragma unroll
    for (int sec = 0; sec < 2; ++sec)
#pragma unroll
        for (int dt = 0; dt < 2; ++dt)
            trb[sec][dt] = 128 * (8 * sec + 4 * h + trq) + 16 * ((4 * dt + 2 * dhalf + (trp >> 1)) ^ ((((trq >> 1) & 1) << 2) | ((2 * sec + h) & 3))) + 8 * (trp & 1);
    bf16x8 qf[4]; u32x4 qn[4]; u32x4 kf[3][4]; u32x4 vr[3][4];
#define AT_DESC(t, ldil_, dil_, res_, qtl_, Pq0_, jmin_) const int ldil_ = 2 * ((t) >> 1), dil_ = 1 << ldil_, _tk##res_ = wave + 8 * ((t) & 1), res_ = _tk##res_ & (dil_ - 1), qtl_ = _tk##res_ >> ldil_, \
        Pq0_ = ((sp * 512) >> ldil_) + 32 * qtl_, jmin_ = (Pq0_ >= 128) ? 0 : 4 - (Pq0_ >> 5)
#define AT_LOADX(res_, dil_, Pq0_, jmin_, j, bi) do { const int _jj = ((j) < jmin_) ? jmin_ : (j); const int _P0 = Pq0_ + 32 * (_jj - 4); \
        const bf16_t* _kp = Pb + (size_t)(res_ + dil_ * (_P0 + lrow)) * INW + 1536 + 64 * hd + 8 * lch; \
        _Pragma("unroll") for (int _s = 0; _s < 4; ++_s) { kf[bi][_s] = *(const u32x4*)(_kp + (size_t)(8 * _s * dil_) * INW); vr[bi][_s] = *(const u32x4*)(_kp + (size_t)(8 * _s * dil_) * INW + 512); } } while (0)
#define AT_LOADQ(dst, res_, dil_, Pq0_) do { const bf16_t* _qp = Pb + (size_t)(res_ + dil_ * (Pq0_ + lrow)) * INW + 1024 + 64 * hd + 8 * lch; \
        _Pragma("unroll") for (int _s = 0; _s < 4; ++_s) dst[_s] = *(const u32x4*)(_qp + (size_t)(8 * _s * dil_) * INW); } while (0)
#define AT_QFRAGS() do { asm volatile("" ::: "memory"); _Pragma("unroll") for (int _s = 0; _s < 4; ++_s) *(LAS u32x4*)(Kimg + wo[_s]) = qn[_s]; asm volatile("" ::: "memory"); \
        _Pragma("unroll") for (int _s = 0; _s < 4; ++_s) qf[_s] = *(const LAS bf16x8*)(Kimg + kro + 16 * (_s ^ krx)); asm volatile("" ::: "memory"); } while (0)
    { AT_DESC(0, l0, d0, r0, q0, P0_, j0); (void)l0; (void)q0;
      AT_LOADQ(qn, r0, d0, P0_); AT_LOADX(r0, d0, P0_, j0, 0, 0); AT_LOADX(r0, d0, P0_, j0, 1, 1); AT_LOADX(r0, d0, P0_, j0, 2, 2); }
    for (int t = 0; t < 6; ++t) {
        {
            const int br = t >> 1;
            AT_DESC(t, ldil, dil, res, qtl, Pq0, jmin);
            const int tn = (t < 5) ? t + 1 : 5;
            AT_DESC(tn, ldiln, diln, resn, qtln, Pq0n, jminn); (void)ldiln; (void)qtln;
            AT_QFRAGS();
            f32x16 o0, o1;
#pragma unroll
            for (int i = 0; i < 16; ++i) { o0[i] = 0.f; o1[i] = 0.f; }
            float m = -INFINITY, lsum = 0.f;
#pragma unroll
            for (int j = 0; j < 5; ++j) {
                const int bi = j % 3;
                if (j >= jmin) {
                    asm volatile("" ::: "memory");
#pragma unroll
                    for (int s = 0; s < 4; ++s) { *(LAS u32x4*)(Kimg + wo[s]) = kf[bi][s]; *(LAS u32x4*)(Vimg + wo[s]) = vr[bi][s]; }
                    asm volatile("" ::: "memory");
                    bf16x8 kfr[4];
#pragma unroll
                    for (int s = 0; s < 4; ++s) kfr[s] = *(const LAS bf16x8*)(Kimg + kro + 16 * (s ^ krx));
                    f32x16 sc;
#pragma unroll
                    for (int i = 0; i < 16; ++i) sc[i] = 0.f;
#pragma unroll
                    for (int s = 0; s < 4; ++s) sc = MFMA32(kfr[s], qf[s], sc);
                    if (j == 0) {
#pragma unroll
                        for (int i = 0; i < 16; ++i) { const int kk = 8 * (i >> 2) + 4 * h + (i & 3); if (kk < r) sc[i] = -INFINITY; }
                    }
                    if (j == 4) {
#pragma unroll
                        for (int i = 0; i < 16; ++i) { const int kk = 8 * (i >> 2) + 4 * h + (i & 3); if (kk > r) sc[i] = -INFINITY; }
                    }
                    float tmax = sc[0];
#pragma unroll
                    for (int i = 1; i < 16; ++i) tmax = fmaxf(tmax, sc[i]);
                    tmax = max_xor32(tmax);
                    const float mnew = fmaxf(m, tmax), alpha = fast_exp2(m - mnew);
                    m = mnew;
                    float psum = 0.f;
#pragma unroll
                    for (int i = 0; i < 16; ++i) { sc[i] = fast_exp2(sc[i] - mnew); psum += sc[i]; }
                    lsum = lsum * alpha + psum;
#pragma unroll
                    for (int i = 0; i < 16; ++i) { o0[i] *= alpha; o1[i] *= alpha; }
                    const bf16x8 pb0 = pack8(sc, 0), pb1 = pack8(sc, 1);
#pragma unroll
                    for (int s2 = 0; s2 < 2; ++s2) {
#pragma unroll
                        for (int dt = 0; dt < 2; ++dt) {
                            const s16x4 lo = __builtin_amdgcn_ds_read_tr16_b64_v4i16((LAS s16x4*)(Vimg + trb[0][dt] + 2048 * s2));
                            const s16x4 hi = __builtin_amdgcn_ds_read_tr16_b64_v4i16((LAS s16x4*)(Vimg + trb[1][dt] + 2048 * s2));
                            const bf16x8 vf = __builtin_shufflevector(lo, hi, 0, 1, 2, 3, 4, 5, 6, 7);
                            if (dt == 0) o0 = MFMA32(vf, s2 ? pb1 : pb0, o0); else o1 = MFMA32(vf, s2 ? pb1 : pb0, o1);
                        }
                    }
                    asm volatile("" ::: "memory");
                }
                if (j + 3 < 5) AT_LOADX(res, dil, Pq0, jmin, j + 3, bi);
                else { if (j == 2) AT_LOADQ(qn, resn, diln, Pq0n); AT_LOADX(resn, diln, Pq0n, jminn, bi, bi); }
            }
            const float ltot = sum_xor32(lsum);
            float lse = m + __builtin_amdgcn_logf(ltot);
            float fn = fast_rcp(ltot), fp = 0.f;
            const int tl = res + dil * (32 * qtl + r);
            LAS unsigned char* orow = Ost + tl * AT_OPITCH + 8 * h;
            if (br > 0) {
                const float lp = Lse[tl], mx = fmaxf(lp, lse), wp = fast_exp2(lp - mx), wn = fast_exp2(lse - mx), den = wp + wn, iden = fast_rcp(den);
                fp = wp * iden; fn = fn * wn * iden; lse = mx + __builtin_amdgcn_logf(den);
            }
            if (br < 2) { if (h == 0) Lse[tl] = lse; }
            bf16_t* grow = mixed + ((size_t)b * SEQ + sp * 512 + tl) * DM + 512 + 64 * hd + 4 * h;
#pragma unroll
            for (int dt = 0; dt < 2; ++dt)
#pragma unroll
                for (int g = 0; g < 4; ++g) {
                    float v0 = (dt ? o1 : o0)[4 * g] * fn, v1 = (dt ? o1 : o0)[4 * g + 1] * fn, v2 = (dt ? o1 : o0)[4 * g + 2] * fn, v3 = (dt ? o1 : o0)[4 * g + 3] * fn;
                    if (br > 0) { const u32x2 pw = *(const LAS u32x2*)(orow + 64 * dt + 16 * g);
                        v0 += fp * __uint_as_float(pw.x << 16); v1 += fp * __uint_as_float(pw.x & 0xffff0000u); v2 += fp * __uint_as_float(pw.y << 16); v3 += fp * __uint_as_float(pw.y & 0xffff0000u); }
                    u32x2 w; w.x = cvt_pk_bf16(v0, v1); w.y = cvt_pk_bf16(v2, v3);
                    if (br < 2) *(LAS u32x2*)(orow + 64 * dt + 16 * g) = w; else *(u32x2*)(grow + 32 * dt + 8 * g) = w;
                }
        }
        if (t & 1) __syncthreads();
    }
#undef AT_DESC
#undef AT_LOADX
#undef AT_LOADQ
#undef AT_QFRAGS
}


#define XB_TMO      128
#define XB_XCNT(j)  (256  + 64 * (j))
#define XB_XSUB(j)  (1280 + 64 * (j))
#define XB_XGEN(j)  (2304 + 64 * (j))
#define XB_TOP      3328
#define XB_TOPGEN   3392
#define XCD_BAR_WORDS 3456
#define XB_SPIN_CAP (1u << 20)
DI unsigned xb_ld(unsigned* p)              { return __hip_atomic_load(p, __ATOMIC_RELAXED, __HIP_MEMORY_SCOPE_AGENT); }
DI unsigned xb_add(unsigned* p, unsigned v) { return __hip_atomic_fetch_add(p, v, __ATOMIC_RELAXED, __HIP_MEMORY_SCOPE_AGENT); }
DI unsigned xb_xcc_id() { return (unsigned)__builtin_amdgcn_s_getreg((3 << 11) | 20) & 0xFu; }
#define XB_SPIN(cond, bar) do { unsigned _sp = 0; while (cond) { __builtin_amdgcn_s_sleep(1); \
    if ((++_sp & 255u) == 0u) { if (xb_ld(&(bar)[XB_TMO])) break; if (_sp > XB_SPIN_CAP) { atomicAdd(&(bar)[XB_TMO], 1u); break; } } } } while (0)
struct XcdBarrier { unsigned* bar; unsigned x; volatile LAS unsigned* st; };
DI XcdBarrier xcd_barrier_post(unsigned* bar, volatile LAS unsigned* st) {
    XcdBarrier b; b.bar = bar; b.x = xb_xcc_id(); b.st = st;
    if (threadIdx.x == 0) (void)xb_add(&bar[XB_XCNT(b.x)], 1u);
    return b;
}
DI void xcd_barrier_complete(unsigned* bar, unsigned x, unsigned& nloc, unsigned& nx) {
    const unsigned G = gridDim.x * gridDim.y * gridDim.z;
    unsigned sum, cnt, mine, sp = 0u;
    for (;;) {
        sum = 0u; cnt = 0u; mine = 0u;
#pragma unroll
        for (unsigned j = 0; j < 16; ++j) { const unsigned c = xb_ld(&bar[XB_XCNT(j)]); sum += c; cnt += (c > 0u) ? 1u : 0u; mine = (j == x) ? c : mine; }
        if (sum == G) break;
        __builtin_amdgcn_s_sleep(1);
        if ((++sp & 255u) == 0u) { if (xb_ld(&bar[XB_TMO])) break; if (sp > XB_SPIN_CAP) { atomicAdd(&bar[XB_TMO], 1u); break; } }
    }
    nloc = mine > 0u ? mine : 1u; nx = cnt > 0u ? cnt : 1u;
}
DI void xcd_barrier(const XcdBarrier& b0, int tid) {
    asm volatile("s_waitcnt vmcnt(0)" ::: "memory");
    __syncthreads();
    if (tid == 0) {
        XcdBarrier b; b.bar = launder_p(b0.bar); b.x = xb_xcc_id(); b.st = b0.st;
        unsigned* bar = b.bar;
        __builtin_amdgcn_s_waitcnt(0);
        unsigned nloc = b.st[0], nx = b.st[1];
        if (nloc == 0u) { xcd_barrier_complete(bar, b.x, nloc, nx); b.st[0] = nloc; b.st[1] = nx; }
        const unsigned old = xb_add(&bar[XB_XSUB(b.x)], 1u);
        const unsigned gen = old / nloc;
        if (old + 1u == (gen + 1u) * nloc) {
            __builtin_amdgcn_fence(__ATOMIC_RELEASE, "agent");
            asm volatile("s_waitcnt vmcnt(0)" ::: "memory");
            const unsigned og = xb_add(&bar[XB_TOP], 1u);
            const unsigned tg = og / nx;
            if (og + 1u == (tg + 1u) * nx) xb_add(&bar[XB_TOPGEN], 1u);
            else XB_SPIN(xb_ld(&bar[XB_TOPGEN]) == tg, bar);
            __builtin_amdgcn_fence(__ATOMIC_ACQUIRE, "agent");
            xb_add(&bar[XB_XGEN(b.x)], 1u);
            asm volatile("s_waitcnt vmcnt(0)" ::: "memory");
        } else {
            XB_SPIN(xb_ld(&bar[XB_XGEN(b.x)]) == gen, bar);
            __builtin_amdgcn_fence(__ATOMIC_ACQUIRE, "agent");
            asm volatile("s_waitcnt vmcnt(0)" ::: "memory");
        }
    }
    __syncthreads();
}

__global__ void __launch_bounds__(NTHR, 2) fwd_megakernel(Params p) {
    extern __shared__ __attribute__((aligned(16))) unsigned char smem[];
    LAS unsigned char* lds = (LAS unsigned char*)smem;
    cg::grid_group grid = cg::this_grid();
    const int tid0 = threadIdx.x;
    const int wave_s = __builtin_amdgcn_readfirstlane(tid0 >> 6);
#define TID() fresh_tid(wave_s)
    unsigned char* ws = p.ws;
    volatile LAS unsigned* bst = (volatile LAS unsigned*)(lds + LDS_BARW);
    if (tid0 < 4) bst[tid0] = 0u;
    __syncthreads();
    const XcdBarrier xbar = xcd_barrier_post((unsigned*)(ws + WS_BAR), bst);

    prelude_phase(p, lds, tid0);
    if (gridDim.x == 0x7fffffffu) grid.sync();
    xcd_barrier(xbar, TID());
    norm0_phase(p.x, p.norm_g, (const float*)(ws + WS_MOD) + DM, (bf16_t*)(ws + WS_Y), (float*)(ws + WS_SSQ), (bf16_t*)(ws + WS_H), TID());
    bias_phase(ws, TID());
    xcd_barrier(xbar, TID());

    for (int l = 0; l < 2; ++l) {
        for (int sb = 0; sb < 3; ++sb) {
            ws = launder_p(ws);
            const float* mod = (const float*)(ws + WS_MOD);
            const float* modl = mod + (size_t)l * 8 * (NADA * DM);
            bf16_t* Y = (bf16_t*)(ws + WS_Y); bf16_t* PG = (bf16_t*)(ws + WS_PG);
            const int slot = l * 3 + sb;
            float* ssq = (float*)(ws + WS_SSQ);
            bf16_t* H = (bf16_t*)(ws + WS_H);
            const bf16_t* A2; const bf16_t* B2; int K2; float gsc;
            if (sb != 1) {
                const int lf = l * 2 + (sb >> 1);
                pg8::Gemm g{Y, (const bf16_t*)(ws + WS_UP + (size_t)lf * SZ_UP), MTOK, 2 * FF, DM};
                pg8::StaticOrder S; S.init(MTOK, 2 * FF, (int)gridDim.x, (int)blockIdx.x);
                EpiSwiglu E{PG, ssq + (size_t)slot * MTOK, (const float*)(ws + WS_BUP) + (size_t)lf * 8 * (2 * FF)};
                pg8::gemm_phase<EpiSwiglu>(lds, g, S, E, TID());
                xcd_barrier(xbar, TID());
                A2 = PG; B2 = (const bf16_t*)(ws + WS_DN + (size_t)lf * SZ_DN); K2 = FF; gsc = 0.5f;
            } else {
                pg8::Gemm g{Y, (const bf16_t*)(ws + WS_IN + (size_t)l * SZ_IN), MTOK, INW, DM};
                pg8::StaticOrder S; S.init(MTOK, INW, (int)gridDim.x, (int)blockIdx.x);
                EpiIn E{PG, (const float*)(ws + WS_ROPE), ssq + (size_t)slot * MTOK, (const float*)(ws + WS_BIN) + (size_t)l * 8 * INW};
                pg8::gemm_phase<EpiIn>(lds, g, S, E, TID());
                xcd_barrier(xbar, TID());
                for (int it = blockIdx.x; it < 1024; it += gridDim.x) sgu_item(p, l, it, lds, TID());
                for (int it = blockIdx.x; it < 512; it += gridDim.x) attn_item(p, it, lds, TID());
                xcd_barrier(xbar, TID());
                A2 = (const bf16_t*)(ws + WS_MIX); B2 = (const bf16_t*)(ws + WS_OUT + (size_t)l * SZ_OUT); K2 = DM; gsc = 1.0f;
            }
            {
                const int ns = slot + 1, nl = ns / 3, nsb = ns % 3;
                pg8::Gemm g{A2, B2, MTOK, DM, K2};
                pg8::StaticOrder S; S.init(MTOK, DM, (int)gridDim.x, (int)blockIdx.x);
                EpiResid E{H, H, modl + (3 * sb + 2) * DM, (ns < 6) ? Y : (bf16_t*)nullptr, ssq + (size_t)ns * MTOK,
                           p.norm_g + (size_t)(ns < 6 ? ns : 0) * DM, mod + (size_t)(ns < 6 ? nl : 0) * 8 * (NADA * DM) + (3 * nsb + 1) * DM, gsc, 0.f};
                pg8::gemm_phase<EpiResid>(lds, g, S, E, TID());
                xcd_barrier(xbar, TID());
            }
        }
    }
    ws = launder_p(ws);
    final_norm_phase((const bf16_t*)(ws + WS_H), p.out, p.final_g, (const float*)(ws + WS_SSQ) + (size_t)6 * MTOK, TID());
}

constexpr int LDS_BYTES = LDS_BARW + 16;
static_assert(LDS_BARW >= 131072 && LDS_BYTES <= 160 * 1024, "LDS map");
extern "C" void kernel_launch(void* const* d_in, const int* in_sizes, int n_in, void* d_out, int out_size, void* d_ws, size_t ws_size, hipStream_t stream) {
    static int grid_blocks = 0;
    if (!grid_blocks) {
        int dev = 0, cus = 0, per_cu = 0;
        hipGetDevice(&dev);
        hipDeviceGetAttribute(&cus, hipDeviceAttributeMultiprocessorCount, dev);
        hipFuncSetAttribute((const void*)fwd_megakernel, hipFuncAttributeMaxDynamicSharedMemorySize, LDS_BYTES);
        hipOccupancyMaxActiveBlocksPerMultiprocessor(&per_cu, (const void*)fwd_megakernel, NTHR, LDS_BYTES);
        if (per_cu < 1) per_cu = 1;
        grid_blocks = cus * per_cu;
        if (ws_size < WS_END) fprintf(stderr, "kernel_launch: workspace too small (%zu < %zu)\n", ws_size, (size_t)WS_END);
    }
    Params p{};
    p.x = (const float*)d_in[0]; p.c = (const float*)d_in[1]; p.ada_w = (const float*)d_in[2]; p.ada_b = (const float*)d_in[3]; p.norm_g = (const float*)d_in[4];
    p.f1g = (const float*)d_in[5]; p.f1u = (const float*)d_in[6]; p.f1d = (const float*)d_in[7]; p.f2g = (const float*)d_in[8]; p.f2u = (const float*)d_in[9]; p.f2d = (const float*)d_in[10];
    p.w_in = (const float*)d_in[11]; p.sgu_ln_g = (const float*)d_in[12]; p.sgu_ln_b = (const float*)d_in[13]; p.sgu_w = (const float*)d_in[14]; p.sgu_b = (const float*)d_in[15];
    p.w_out = (const float*)d_in[16]; p.final_g = (const float*)d_in[17];
    p.out = (float*)d_out; p.ws = (unsigned char*)d_ws;
    (void)hipMemsetAsync((unsigned char*)d_ws + WS_BAR, 0, ZERO_BYTES, stream);
    void* args[] = {&p};
    hipError_t e = hipLaunchCooperativeKernel((const void*)fwd_megakernel, dim3(grid_blocks), dim3(NTHR), args, LDS_BYTES, stream);
    if (e != hipSuccess) fprintf(stderr, "cooperative launch failed: %s (grid %d)\n", hipGetErrorString(e), grid_blocks);
}
```
